# Optimizing an MI355X kernel written in HIP

```python
import math
import jax, jax.numpy as jnp
from jax import lax
import numpy as np

D_MODEL = 1024
BATCH = 16
SEQ = 2048
DEPTH = 1

CHUNK = 64
Q_BLOCK = 128
HEAD_DIM = 64
DIFF_HEADS = 4
DIFF_V_DIM = 2 * HEAD_DIM
DIFF_WIDTH = DIFF_HEADS * DIFF_V_DIM
FOX_HEADS = 8
FOX_WIDTH = FOX_HEADS * HEAD_DIM
N_BRANCHES = 2
D_FF = 4 * D_MODEL
REL_BUCKETS = 32
REL_MAX_DIST = 128
EPS = 1e-6
FORGET_BIAS_INIT = 2.0

DIFF_QK_COLS = DIFF_HEADS * 2 * HEAD_DIM
COL_SIZES = [DIFF_QK_COLS, DIFF_QK_COLS, DIFF_WIDTH,
             FOX_WIDTH, FOX_WIDTH, FOX_WIDTH, FOX_HEADS,
             N_BRANCHES * D_MODEL]
IN_COLS = sum(COL_SIZES)
SPLITS = [sum(COL_SIZES[:i + 1]) for i in range(len(COL_SIZES) - 1)]

kernel_name = "hybrid_diff_fox_gated_encoder"


def rmsnorm(x, g):
    xf = x.astype(jnp.float32)
    y = xf * lax.rsqrt(jnp.mean(xf * xf, axis=-1, keepdims=True) + EPS)
    return (y * g.astype(jnp.float32)).astype(x.dtype)


def lambda_init_fn(layer_idx):
    return 0.8 - 0.6 * math.exp(-0.3 * layer_idx)


def rel_bucket(rel):
    nb = REL_BUCKETS // 2
    ret = jnp.where(rel > 0, nb, 0)
    n = jnp.abs(rel)
    max_exact = nb // 2
    nf = jnp.maximum(n, 1).astype(jnp.float32)
    large = max_exact + (jnp.log(nf / max_exact) / math.log(REL_MAX_DIST / max_exact)
                         * (nb - max_exact)).astype(jnp.int32)
    large = jnp.minimum(large, nb - 1)
    return ret + jnp.where(n < max_exact, n, large)


def attention_branches(q_d, k_d, v_d, q_f, k_f, v_f, fcum, rel_table, lam):
    S = q_d.shape[1]
    scale = HEAD_DIM ** -0.5
    pos = jnp.arange(S, dtype=jnp.int32)
    outs_d, outs_f = [], []
    for blk in range(S // Q_BLOCK):
        q0 = blk * Q_BLOCK
        kend = q0 + Q_BLOCK
        qp = pos[q0:kend]
        kp = pos[:kend]
        rel = kp[None, :] - qp[:, None]
        bias = jnp.transpose(rel_table[rel_bucket(rel)], (2, 0, 1))
        chunk_mask = (kp[None, :] // CHUNK) <= (qp[:, None] // CHUNK)
        frame_mask = kp[None, :] <= qp[:, None]

        s_d = jnp.einsum('bqhmd,bkhmd->bhmqk', q_d[:, q0:kend], k_d[:, :kend]).astype(jnp.float32)
        s_d = s_d * scale + bias[None, :, None].astype(jnp.float32)
        s_d = jnp.where(chunk_mask, s_d, -jnp.inf)
        p_d = jax.nn.softmax(s_d, axis=-1)
        w_d = p_d[:, :, 0] - lam * p_d[:, :, 1]
        outs_d.append(jnp.einsum('bhqk,bkhe->bqhe', w_d.astype(v_d.dtype), v_d[:, :kend]))

        s_f = jnp.einsum('bqhd,bkhd->bhqk', q_f[:, q0:kend], k_f[:, :kend]).astype(jnp.float32)
        s_f = s_f * scale + (fcum[:, :, q0:kend, None] - fcum[:, :, None, :kend])
        s_f = jnp.where(frame_mask, s_f, -jnp.inf)
        p_f = jax.nn.softmax(s_f, axis=-1)
        outs_f.append(jnp.einsum('bhqk,bkhd->bqhd', p_f.astype(v_f.dtype), v_f[:, :kend]))
    return jnp.concatenate(outs_d, axis=1), jnp.concatenate(outs_f, axis=1)


def hybrid_layer(x, layer_idx, g_mix, w_in, b_f, lam_q1, lam_k1, lam_q2, lam_k2, g_subln,
                 w_pa, w_pb, w_o, g_mlp, w_1, w_2, rel_table):
    B, S, _ = x.shape
    h = rmsnorm(x, g_mix)
    proj = h @ w_in
    dq, dk, dv, fq, fk, fv, fl, gl = jnp.split(proj, SPLITS, axis=-1)
    q_d = dq.reshape(B, S, DIFF_HEADS, 2, HEAD_DIM)
    k_d = dk.reshape(B, S, DIFF_HEADS, 2, HEAD_DIM)
    v_d = dv.reshape(B, S, DIFF_HEADS, DIFF_V_DIM)
    q_f = fq.reshape(B, S, FOX_HEADS, HEAD_DIM)
    k_f = fk.reshape(B, S, FOX_HEADS, HEAD_DIM)
    v_f = fv.reshape(B, S, FOX_HEADS, HEAD_DIM)

    logf = jax.nn.log_sigmoid((fl + b_f).astype(jnp.float32))
    fcum = jnp.transpose(jnp.cumsum(logf, axis=1), (0, 2, 1))

    lam_init = lambda_init_fn(layer_idx)
    lam = (jnp.exp(jnp.sum(lam_q1.astype(jnp.float32) * lam_k1.astype(jnp.float32)))
           - jnp.exp(jnp.sum(lam_q2.astype(jnp.float32) * lam_k2.astype(jnp.float32)))
           + lam_init)

    o_d, o_f = attention_branches(q_d, k_d, v_d, q_f, k_f, v_f, fcum, rel_table, lam)
    o_d = (rmsnorm(o_d, g_subln) * (1.0 - lam_init)).reshape(B, S, DIFF_WIDTH)
    o_f = o_f.reshape(B, S, FOX_WIDTH)

    gates = jax.nn.sigmoid(gl.astype(jnp.float32)).astype(x.dtype).reshape(B, S, N_BRANCHES, D_MODEL)
    merged = gates[:, :, 0] * (o_d @ w_pa) + gates[:, :, 1] * (o_f @ w_pb)
    x = x + merged @ w_o

    h2 = rmsnorm(x, g_mlp)
    x = x + jnp.square(jax.nn.relu(h2 @ w_1)) @ w_2
    return x


def setup_inputs(seed: int = 0) -> dict:
    key = jax.random.key(seed)
    ks = jax.random.split(key, 20)
    f32 = jnp.float32
    nrm = lambda k, shape, s: (jax.random.normal(k, shape, f32) * s)
    return {
        "x": nrm(ks[0], (BATCH, SEQ, D_MODEL), 1.0),
        "g_mix": 1.0 + nrm(ks[1], (DEPTH, D_MODEL), 0.05),
        "w_in": nrm(ks[2], (DEPTH, D_MODEL, IN_COLS), D_MODEL ** -0.5),
        "b_f": FORGET_BIAS_INIT + nrm(ks[3], (DEPTH, FOX_HEADS), 0.1),
        "lam_q1": nrm(ks[4], (DEPTH, HEAD_DIM), 0.1),
        "lam_k1": nrm(ks[5], (DEPTH, HEAD_DIM), 0.1),
        "lam_q2": nrm(ks[6], (DEPTH, HEAD_DIM), 0.1),
        "lam_k2": nrm(ks[7], (DEPTH, HEAD_DIM), 0.1),
        "g_subln": 1.0 + nrm(ks[8], (DEPTH, DIFF_V_DIM), 0.05),
        "w_pa": nrm(ks[9], (DEPTH, DIFF_WIDTH, D_MODEL), DIFF_WIDTH ** -0.5),
        "w_pb": nrm(ks[10], (DEPTH, FOX_WIDTH, D_MODEL), FOX_WIDTH ** -0.5),
        "w_o": nrm(ks[11], (DEPTH, D_MODEL, D_MODEL), D_MODEL ** -0.5),
        "g_mlp": 1.0 + nrm(ks[12], (DEPTH, D_MODEL), 0.05),
        "w_1": nrm(ks[13], (DEPTH, D_MODEL, D_FF), D_MODEL ** -0.5),
        "w_2": nrm(ks[14], (DEPTH, D_FF, D_MODEL), D_FF ** -0.5),
        "rel_table": nrm(ks[15], (REL_BUCKETS, DIFF_HEADS), 0.5),
        "g_final": 1.0 + nrm(ks[16], (D_MODEL,), 0.05),
    }


def reference(x, g_mix, w_in, b_f, lam_q1, lam_k1, lam_q2, lam_k2, g_subln, w_pa, w_pb, w_o,
              g_mlp, w_1, w_2, rel_table, g_final):
    for l in range(DEPTH):
        x = hybrid_layer(x, l, g_mix[l], w_in[l], b_f[l], lam_q1[l], lam_k1[l], lam_q2[l],
                         lam_k2[l], g_subln[l], w_pa[l], w_pb[l], w_o[l], g_mlp[l], w_1[l],
                         w_2[l], rel_table)
    return rmsnorm(x, g_final)
```

```cpp
#include <hip/hip_runtime.h>
#include <hip/hip_cooperative_groups.h>
#include <cstdio>
#include <cstdint>
namespace cg = cooperative_groups;

#ifndef ONE_LAUNCH
#define ONE_LAUNCH 0
#endif

typedef unsigned short bf16_t;
typedef short bf16x8 __attribute__((ext_vector_type(8)));
typedef float f32x4 __attribute__((ext_vector_type(4)));
typedef float f32x16 __attribute__((ext_vector_type(16)));

constexpr int BATCH = 16, SEQ = 2048, DM = 1024, M = BATCH * SEQ, INC = 5128, NP = 5120, FF = 4096;
constexpr float EPS = 1e-6f, LOG2E = 1.4426950408889634f, C2 = 0.125f * LOG2E;
constexpr int C_DQ = 0, C_DK = 512, C_DV = 1024, C_FQ = 1536, C_FK = 2048, C_FV = 2560, C_G0 = 3072, C_G1 = 4096;
constexpr int C_OD = 0, C_MRG = 512, C_OF = 1536, C_T1 = 2048;

constexpr size_t MiB = 1u << 20;
constexpr size_t WS_WIN = 0, WS_WPA = 10 * MiB, WS_WPB = 11 * MiB, WS_WO = 12 * MiB, WS_W1 = 14 * MiB, WS_W2 = 22 * MiB;
constexpr size_t WS_LOGF = 30 * MiB, WS_FC = 31 * MiB, WS_BT = 32 * MiB, WS_XN = 34 * MiB, WS_PROJ = 98 * MiB, WS_END = 418 * MiB;

struct Params {
    const float* x; const float* g_mix; const float* w_in; const float* b_f; const float* lq1; const float* lk1; const float* lq2; const float* lk2;
    const float* g_subln; const float* w_pa; const float* w_pb; const float* w_o; const float* g_mlp; const float* w_1; const float* w_2; const float* rel_table; const float* g_final;
    float* out; unsigned char* ws;
};

__device__ __forceinline__ unsigned f2bf(float f) { unsigned u = __builtin_bit_cast(unsigned, f); return (u + 0x7fffu + ((u >> 16) & 1u)) >> 16; }
__device__ __forceinline__ unsigned pk2(float lo, float hi) { return f2bf(lo) | (f2bf(hi) << 16); }
__device__ __forceinline__ float bf2f(bf16_t b) { return __builtin_bit_cast(float, (unsigned)b << 16); }
__device__ __forceinline__ float wave_sum(float v) {
#pragma unroll
    for (int o = 1; o < 64; o <<= 1) v += __shfl_xor(v, o);
    return v;
}
__device__ __forceinline__ int crow(int r, int hi) { return (r & 3) + 8 * (r >> 2) + 4 * hi; }

__device__ __forceinline__ void transpose_item(const float* W, int ldw, int K, bf16_t* WT, float* scr, int kb, int nb, int lane) {
    const int k0 = 64 * kb, n0 = 32 * nb;
#pragma unroll 8
    for (int i = 0; i < 32; ++i) { const int kk = 2 * i + (lane >> 5); scr[kk * 33 + (lane & 31)] = W[(size_t)(k0 + kk) * ldw + n0 + (lane & 31)]; }
    __builtin_amdgcn_fence(__ATOMIC_RELEASE, "wavefront"); __builtin_amdgcn_wave_barrier(); __builtin_amdgcn_fence(__ATOMIC_ACQUIRE, "wavefront");
    const int c = lane & 7;
#pragma unroll
    for (int j = 0; j < 4; ++j) { const int n = (lane >> 3) + 8 * j; const float* s = scr + (8 * c) * 33 + n;
        uint4 o; o.x = pk2(s[0 * 33], s[1 * 33]); o.y = pk2(s[2 * 33], s[3 * 33]); o.z = pk2(s[4 * 33], s[5 * 33]); o.w = pk2(s[6 * 33], s[7 * 33]);
        *(uint4*)(WT + (size_t)(n0 + n) * K + k0 + 8 * c) = o; }
    __builtin_amdgcn_fence(__ATOMIC_RELEASE, "wavefront"); __builtin_amdgcn_wave_barrier(); __builtin_amdgcn_fence(__ATOMIC_ACQUIRE, "wavefront");
}

__device__ __forceinline__ int rel_bucket(int rel) {
    const int ret = rel > 0 ? 16 : 0; const int n = rel < 0 ? -rel : rel;
    int v;
    if (n < 8) v = n; else { int lg = (31 - __clz(n * n)) - 6; v = 8 + lg; if (v > 15) v = 15; }
    return ret + v;
}

__device__ __forceinline__ void norm_row(const float* xrow, const float* g, bf16_t* orow, const float* wfl  , const float* b_f, float* logf_row, int lane) {
    f32x4 v[4]; float s = 0.f;
#pragma unroll
    for (int j = 0; j < 4; ++j) { v[j] = *(const f32x4*)(xrow + 4 * lane + 256 * j); s += (v[j].x * v[j].x + v[j].y * v[j].y) + (v[j].z * v[j].z + v[j].w * v[j].w); }
    const float r = 1.0f / sqrtf(wave_sum(s) * (1.f / DM) + EPS);
    float fl[8];
#pragma unroll
    for (int h = 0; h < 8; ++h) fl[h] = 0.f;
#pragma unroll
    for (int j = 0; j < 4; ++j) {
        const f32x4 gg = *(const f32x4*)(g + 4 * lane + 256 * j);
        f32x4 y; y.x = v[j].x * r * gg.x; y.y = v[j].y * r * gg.y; y.z = v[j].z * r * gg.z; y.w = v[j].w * r * gg.w;
        uint2 o; o.x = pk2(y.x, y.y); o.y = pk2(y.z, y.w);
        *(uint2*)(orow + 4 * lane + 256 * j) = o;
        if (wfl) {
#pragma unroll
            for (int e = 0; e < 4; ++e) { const int k = 4 * lane + 256 * j + e; const float yy = y[e];
                const f32x4 w0 = *(const f32x4*)(wfl + (size_t)k * INC), w1 = *(const f32x4*)(wfl + (size_t)k * INC + 4);
                fl[0] += yy * w0.x; fl[1] += yy * w0.y; fl[2] += yy * w0.z; fl[3] += yy * w0.w; fl[4] += yy * w1.x; fl[5] += yy * w1.y; fl[6] += yy * w1.z; fl[7] += yy * w1.w; }
        }
    }
    if (wfl) {
#pragma unroll
        for (int h = 0; h < 8; ++h) fl[h] = wave_sum(fl[h]);
        if (lane < 8) { float z = 0.f;
#pragma unroll
            for (int h = 0; h < 8; ++h) if (lane == h) z = fl[h];
            z += b_f[lane];
            const float ls = fminf(z, 0.f) - log1pf(expf(-fabsf(z)));
            logf_row[lane] = ls; }
    }
}

__device__ void phase_prologue(const Params& P, float* lds, int bid, int nblk) {
    const int tid = threadIdx.x, lane = tid & 63, wave = tid >> 6, nw = blockDim.x >> 6;
    const int gw = bid * nw + wave, NGW = nblk * nw;
    float* scr = lds + wave * (64 * 33);
    unsigned char* ws = P.ws;
    constexpr int I_INA = 16 * 96, I_INB = 16 * 64, I_PA = 8 * 32, I_PB = 8 * 32, I_O = 16 * 32, I_1 = 16 * 128, I_2 = 64 * 32;
    constexpr int NITEMS = I_INA + I_INB + I_PA + I_PB + I_O + I_1 + I_2;
    for (int it = gw; it < NITEMS; it += NGW) {
        int r = it;
        if (r < I_INA) { transpose_item(P.w_in, INC, 1024, (bf16_t*)(ws + WS_WIN), scr, r / 96, r % 96, lane); continue; } r -= I_INA;
        if (r < I_INB) { transpose_item(P.w_in + 3080, INC, 1024, (bf16_t*)(ws + WS_WIN) + (size_t)3072 * 1024, scr, r / 64, r % 64, lane); continue; } r -= I_INB;
        if (r < I_PA) { transpose_item(P.w_pa, 1024, 512, (bf16_t*)(ws + WS_WPA), scr, r / 32, r % 32, lane); continue; } r -= I_PA;
        if (r < I_PB) { transpose_item(P.w_pb, 1024, 512, (bf16_t*)(ws + WS_WPB), scr, r / 32, r % 32, lane); continue; } r -= I_PB;
        if (r < I_O) { transpose_item(P.w_o, 1024, 1024, (bf16_t*)(ws + WS_WO), scr, r / 32, r % 32, lane); continue; } r -= I_O;
        if (r < I_1) { transpose_item(P.w_1, 4096, 1024, (bf16_t*)(ws + WS_W1), scr, r / 128, r % 128, lane); continue; } r -= I_1;
        transpose_item(P.w_2, 1024, 4096, (bf16_t*)(ws + WS_W2), scr, r / 32, r % 32, lane);
    }
    if (bid == 0) {
        float* BT = (float*)(ws + WS_BT);
        for (int i = tid; i < 4 * 256; i += blockDim.x) { const int h = i >> 8, rel = (i & 255) - 192;
            BT[i] = (P.rel_table[rel_bucket(rel) * 4 + h] - P.rel_table[15 * 4 + h]) * LOG2E; }
    }
    for (int m = gw; m < M; m += NGW)
        norm_row(P.x + (size_t)m * DM, P.g_mix, (bf16_t*)(ws + WS_XN) + (size_t)m * DM, P.w_in + 3072, P.b_f, (float*)(ws + WS_LOGF) + (size_t)m * 8, lane);
}

__device__ void phase_cumsum(const Params& P, int bid, int nblk) {
    const int tid = threadIdx.x, lane = tid & 63, wave = tid >> 6, nw = blockDim.x >> 6;
    const int gw = bid * nw + wave, NGW = nblk * nw;
    const float* LF = (const float*)(P.ws + WS_LOGF); float* FC = (float*)(P.ws + WS_FC);
    for (int seq = gw; seq < BATCH * 8; seq += NGW) {
        const int b = seq >> 3, h = seq & 7;
        const size_t base = ((size_t)b * SEQ + lane * 32) * 8 + h;
        float loc[32]; float run = 0.f;
#pragma unroll
        for (int i = 0; i < 32; ++i) { run += LF[base + (size_t)i * 8]; loc[i] = run; }
        float incl = run;
#pragma unroll
        for (int o = 1; o < 64; o <<= 1) { const float t = __shfl_up(incl, o); if (lane >= o) incl += t; }
        const float excl = incl - run;
#pragma unroll
        for (int i = 0; i < 32; ++i) FC[base + (size_t)i * 8] = (loc[i] + excl) * LOG2E;
    }
}

template <class Epi>
__device__ void gemm_simple(const bf16_t* A, int lda, const bf16_t* Bt, int ldb, int Mr, int N, int K, const Epi& epi, unsigned char* smem, int bid, int nblk) {
    constexpr int LP = 40;
    bf16_t* sA = (bf16_t*)smem; bf16_t* sB = sA + 128 * LP;
    const int tid = threadIdx.x, lane = tid & 63, wave = tid >> 6, wr = wave >> 1, wc = wave & 1, r32 = lane & 31, hi = lane >> 5;
    const int tilesN = N / 128, tiles = (Mr / 128) * tilesN;
    for (int t = bid; t < tiles; t += nblk) {
        const int m0 = (t / tilesN) * 128, n0 = (t % tilesN) * 128;
        f32x16 acc[2][2];
#pragma unroll
        for (int i = 0; i < 2; ++i)
#pragma unroll
            for (int j = 0; j < 2; ++j) acc[i][j] = f32x16{};
        for (int k0 = 0; k0 < K; k0 += 32) {
            __syncthreads();
#pragma unroll
            for (int i = 0; i < 2; ++i) { const int row = (tid >> 2) + 64 * i, ch = tid & 3;
                *(uint4*)(sA + row * LP + ch * 8) = *(const uint4*)(A + (size_t)(m0 + row) * lda + k0 + ch * 8);
                *(uint4*)(sB + row * LP + ch * 8) = *(const uint4*)(Bt + (size_t)(n0 + row) * ldb + k0 + ch * 8); }
            __syncthreads();
#pragma unroll
            for (int kk = 0; kk < 2; ++kk) {
                bf16x8 a[2], b[2];
#pragma unroll
                for (int i = 0; i < 2; ++i) { a[i] = *(const bf16x8*)(sA + (wr * 64 + i * 32 + r32) * LP + kk * 16 + hi * 8); b[i] = *(const bf16x8*)(sB + (wc * 64 + i * 32 + r32) * LP + kk * 16 + hi * 8); }
#pragma unroll
                for (int i = 0; i < 2; ++i)
#pragma unroll
                    for (int j = 0; j < 2; ++j) acc[i][j] = __builtin_amdgcn_mfma_f32_32x32x16_bf16(a[i], b[j], acc[i][j], 0, 0, 0);
            }
        }
#pragma unroll
        for (int i = 0; i < 2; ++i)
#pragma unroll
            for (int j = 0; j < 2; ++j)
#pragma unroll
                for (int r = 0; r < 16; ++r) epi(m0 + wr * 64 + i * 32 + crow(r, hi), n0 + wc * 64 + j * 32 + r32, acc[i][j][r]);
    }
}

struct EpiProj { bf16_t* PROJ;
    __device__ __forceinline__ void operator()(int row, int col, float v) const {
        float o;
        if (col < C_G0) { const bool isq = (col < 512) || (col >= C_FQ && col < C_FK); o = isq ? v * C2 : v; }
        else o = 1.0f / (1.0f + __expf(-v));
        PROJ[(size_t)row * NP + col] = (bf16_t)f2bf(o); } };
struct EpiT1 { bf16_t* PROJ;
    __device__ __forceinline__ void operator()(int row, int col, float v) const { bf16_t* p = PROJ + (size_t)row * NP; p[C_T1 + col] = (bf16_t)f2bf(v * bf2f(p[C_G0 + col])); } };
struct EpiMrg { bf16_t* PROJ;
    __device__ __forceinline__ void operator()(int row, int col, float v) const { bf16_t* p = PROJ + (size_t)row * NP; p[C_MRG + col] = (bf16_t)f2bf(bf2f(p[C_T1 + col]) + v * bf2f(p[C_G1 + col])); } };
struct EpiX1 { const float* x; float* out;
    __device__ __forceinline__ void operator()(int row, int col, float v) const { const size_t i = (size_t)row * DM + col; out[i] = x[i] + v; } };
struct EpiUp { bf16_t* HH;
    __device__ __forceinline__ void operator()(int row, int col, float v) const { const float t = fmaxf(v, 0.f); HH[(size_t)row * FF + col] = (bf16_t)f2bf(t * t); } };
struct EpiDown { float* out;
    __device__ __forceinline__ void operator()(int row, int col, float v) const { const size_t i = (size_t)row * DM + col; out[i] += v; } };

template <int MODE>
__device__ void attn_wave(const bf16_t* Qp, const bf16_t* Kp, const bf16_t* Vp, bf16_t* Op, int opitch, int q0, const float* fc  , const float* bt, int lane) {
    constexpr int NDB = MODE == 0 ? 2 : 4;
    const int r32 = lane & 31, hi = lane >> 5;
    bf16x8 qr[4];
#pragma unroll
    for (int d0 = 0; d0 < 4; ++d0) qr[d0] = *(const bf16x8*)(Qp + (size_t)(q0 + r32) * NP + d0 * 16 + hi * 8);
    f32x16 o[NDB];
#pragma unroll
    for (int d = 0; d < NDB; ++d) o[d] = f32x16{};
    float mrun = -INFINITY, lrun = 0.f;
    const int q = q0 + r32;
    const int kend = MODE == 0 ? q0 + 32 : ((q0 >> 6) + 1) * 64;
    for (int kv0 = 0; kv0 < kend; kv0 += 32) {
        f32x16 s = f32x16{};
#pragma unroll
        for (int d0 = 0; d0 < 4; ++d0) { const bf16x8 kf = *(const bf16x8*)(Kp + (size_t)(kv0 + r32) * NP + d0 * 16 + hi * 8);
            s = __builtin_amdgcn_mfma_f32_32x32x16_bf16(kf, qr[d0], s, 0, 0, 0); }
        float tmax = -INFINITY;
#pragma unroll
        for (int r = 0; r < 16; ++r) { const int kv = kv0 + crow(r, hi);
            if (MODE == 0) { s[r] = (kv > q) ? -INFINITY : s[r] - fc[(size_t)kv * 8]; }
            else { int rel = kv - q; if (rel < -192) rel = -192; s[r] += bt[rel + 192]; }
            tmax = fmaxf(tmax, s[r]); }
        tmax = fmaxf(tmax, __shfl_xor(tmax, 32));
        const float mnew = fmaxf(mrun, tmax);
        const float alpha = exp2f(mrun - mnew);
        mrun = mnew;
        float psum = 0.f;
#pragma unroll
        for (int r = 0; r < 16; ++r) { s[r] = exp2f(s[r] - mnew); psum += s[r]; }
        lrun = lrun * alpha + psum;
#pragma unroll
        for (int r = 0; r < 16; ++r) { const float a = __shfl(alpha, crow(r, hi));
#pragma unroll
            for (int d = 0; d < NDB; ++d) o[d][r] *= a; }
#pragma unroll
        for (int st = 0; st < 2; ++st) {
            bf16x8 pa;
#pragma unroll
            for (int j = 0; j < 8; ++j) pa[j] = (short)f2bf(s[8 * st + j]);
#pragma unroll
            for (int d = 0; d < NDB; ++d) {
                bf16x8 vb;
#pragma unroll
                for (int j = 0; j < 8; ++j) { const int kv = kv0 + 16 * st + 8 * (j >> 2) + 4 * hi + (j & 3); vb[j] = (short)Vp[(size_t)kv * NP + d * 32 + r32]; }
                o[d] = __builtin_amdgcn_mfma_f32_32x32x16_bf16(pa, vb, o[d], 0, 0, 0);
            }
        }
    }
    const float ltot = lrun + __shfl_xor(lrun, 32);
    const float linv = 1.0f / ltot;
#pragma unroll
    for (int r = 0; r < 16; ++r) { const int qr_ = crow(r, hi); const float li = __shfl(linv, qr_);
#pragma unroll
        for (int d = 0; d < NDB; ++d) Op[(size_t)(q0 + qr_) * opitch + d * 32 + r32] = (bf16_t)f2bf(o[d][r] * li); }
}

__device__ void phase_attention(const Params& P, int bid, int nblk) {
    const int tid = threadIdx.x, lane = tid & 63, wave = tid >> 6, nw = blockDim.x >> 6;
    const int gw = bid * nw + wave, NGW = nblk * nw;
    bf16_t* PROJ = (bf16_t*)(P.ws + WS_PROJ); bf16_t* ODRAW = (bf16_t*)(P.ws + WS_XN);
    const float* FC = (const float*)(P.ws + WS_FC); const float* BT = (const float*)(P.ws + WS_BT);
    const int NIT = 64 * BATCH * 16;
    for (int it = gw; it < NIT; it += NGW) {
        const int qb = 63 - it / (BATCH * 16), rem = it % (BATCH * 16), b = rem >> 4, vh = rem & 15;
        const size_t rb = (size_t)b * SEQ;
        if (vh < 8) {
            const int h = vh; bf16_t* base = PROJ + rb * NP;
            attn_wave<0>(base + C_FQ + h * 64, base + C_FK + h * 64, base + C_FV + h * 64, base + C_OF + h * 64, NP, qb * 32, FC + rb * 8 + h, nullptr, lane);
        } else {
            const int h = (vh - 8) >> 1, mp = (vh - 8) & 1; bf16_t* base = PROJ + rb * NP;
            attn_wave<1>(base + C_DQ + h * 128 + mp * 64, base + C_DK + h * 128 + mp * 64, base + C_DV + h * 128, ODRAW + rb * 1024 + h * 256 + mp * 128, 1024, qb * 32, nullptr, BT + h * 256, lane);
        }
    }
}

__device__ void phase_combine(const Params& P, int bid, int nblk) {
    const int tid = threadIdx.x, lane = tid & 63, wave = tid >> 6, nw = blockDim.x >> 6;
    const int gw = bid * nw + wave, NGW = nblk * nw;
    const float s1 = wave_sum(P.lq1[lane] * P.lk1[lane]), s2 = wave_sum(P.lq2[lane] * P.lk2[lane]);
    const float lam = expf(s1) - expf(s2) + 0.2f;
    bf16_t* PROJ = (bf16_t*)(P.ws + WS_PROJ); const bf16_t* ODRAW = (const bf16_t*)(P.ws + WS_XN);
    const int h = lane >> 4, e0 = (lane & 15) * 8;
    float g[8];
#pragma unroll
    for (int j = 0; j < 8; ++j) g[j] = P.g_subln[e0 + j] * 0.8f;
    for (int m = gw; m < M; m += NGW) {
        const bf16x8 a = *(const bf16x8*)(ODRAW + (size_t)m * 1024 + h * 256 + e0), b = *(const bf16x8*)(ODRAW + (size_t)m * 1024 + h * 256 + 128 + e0);
        float v[8]; float ss = 0.f;
#pragma unroll
        for (int j = 0; j < 8; ++j) { v[j] = bf2f((bf16_t)a[j]) - lam * bf2f((bf16_t)b[j]); ss += v[j] * v[j]; }
        ss += __shfl_xor(ss, 1); ss += __shfl_xor(ss, 2); ss += __shfl_xor(ss, 4); ss += __shfl_xor(ss, 8);
        const float r = 1.0f / sqrtf(ss * (1.f / 128.f) + EPS);
        uint4 o; o.x = pk2(v[0] * r * g[0], v[1] * r * g[1]); o.y = pk2(v[2] * r * g[2], v[3] * r * g[3]); o.z = pk2(v[4] * r * g[4], v[5] * r * g[5]); o.w = pk2(v[6] * r * g[6], v[7] * r * g[7]);
        *(uint4*)(PROJ + (size_t)m * NP + C_OD + h * 128 + e0) = o;
    }
}

__device__ void phase_norm2(const Params& P, int bid, int nblk) {
    const int tid = threadIdx.x, lane = tid & 63, wave = tid >> 6, nw = blockDim.x >> 6;
    const int gw = bid * nw + wave, NGW = nblk * nw;
    for (int m = gw; m < M; m += NGW) norm_row(P.out + (size_t)m * DM, P.g_mlp, (bf16_t*)(P.ws + WS_XN) + (size_t)m * DM, nullptr, nullptr, nullptr, lane);
}
__device__ void phase_final(const Params& P, int bid, int nblk) {
    const int tid = threadIdx.x, lane = tid & 63, wave = tid >> 6, nw = blockDim.x >> 6;
    const int gw = bid * nw + wave, NGW = nblk * nw;
    for (int m = gw; m < M; m += NGW) {
        float* row = P.out + (size_t)m * DM; f32x4 v[4]; float s = 0.f;
#pragma unroll
        for (int j = 0; j < 4; ++j) { v[j] = *(const f32x4*)(row + 4 * lane + 256 * j); s += (v[j].x * v[j].x + v[j].y * v[j].y) + (v[j].z * v[j].z + v[j].w * v[j].w); }
        const float r = 1.0f / sqrtf(wave_sum(s) * (1.f / DM) + EPS);
#pragma unroll
        for (int j = 0; j < 4; ++j) { const f32x4 gg = *(const f32x4*)(P.g_final + 4 * lane + 256 * j); f32x4 y; y.x = v[j].x * r * gg.x; y.y = v[j].y * r * gg.y; y.z = v[j].z * r * gg.z; y.w = v[j].w * r * gg.w;
            *(f32x4*)(row + 4 * lane + 256 * j) = y; }
    }
}

constexpr int NPHASE = 11;
__device__ __forceinline__ void run_phase(const Params& P, int ph, unsigned char* smem, int bid, int nblk) {
    bf16_t* PROJ = (bf16_t*)(P.ws + WS_PROJ);
    switch (ph) {
    case 0: phase_prologue(P, (float*)smem, bid, nblk); break;
    case 1: phase_cumsum(P, bid, nblk);
            gemm_simple((const bf16_t*)(P.ws + WS_XN), DM, (const bf16_t*)(P.ws + WS_WIN), 1024, M, NP, 1024, EpiProj{PROJ}, smem, bid, nblk); break;
    case 2: phase_attention(P, bid, nblk); break;
    case 3: phase_combine(P, bid, nblk); break;
    case 4: gemm_simple(PROJ + C_OD, NP, (const bf16_t*)(P.ws + WS_WPA), 512, M, 1024, 512, EpiT1{PROJ}, smem, bid, nblk); break;
    case 5: gemm_simple(PROJ + C_OF, NP, (const bf16_t*)(P.ws + WS_WPB), 512, M, 1024, 512, EpiMrg{PROJ}, smem, bid, nblk); break;
    case 6: gemm_simple(PROJ + C_MRG, NP, (const bf16_t*)(P.ws + WS_WO), 1024, M, 1024, 1024, EpiX1{P.x, P.out}, smem, bid, nblk); break;
    case 7: phase_norm2(P, bid, nblk); break;
    case 8: gemm_simple((const bf16_t*)(P.ws + WS_XN), DM, (const bf16_t*)(P.ws + WS_W1), 1024, M, FF, 1024, EpiUp{PROJ}, smem, bid, nblk); break;
    case 9: gemm_simple(PROJ, FF, (const bf16_t*)(P.ws + WS_W2), 4096, M, 1024, 4096, EpiDown{P.out}, smem, bid, nblk); break;
    case 10: phase_final(P, bid, nblk); break;
    }
}

constexpr int SMEM_BYTES = 4 * 64 * 33 * 4;

#if ONE_LAUNCH
__global__ void __launch_bounds__(256) fwd_mega(Params P) {
    __shared__ __attribute__((aligned(16))) unsigned char smem[SMEM_BYTES];
    cg::grid_group grid = cg::this_grid();
    for (int ph = 0; ph < NPHASE; ++ph) { run_phase(P, ph, smem, blockIdx.x, gridDim.x); if (ph + 1 < NPHASE) grid.sync(); }
}
#else
__global__ void __launch_bounds__(256) fwd_phase(Params P, int ph) {
    __shared__ __attribute__((aligned(16))) unsigned char smem[SMEM_BYTES];
    run_phase(P, ph, smem, blockIdx.x, gridDim.x);
}
#endif

extern "C" void kernel_launch(void* const* d_in, const int* in_sizes, int n_in, void* d_out, int out_size, void* d_ws, size_t ws_size, hipStream_t stream) {
    if (n_in != 17 || out_size != M * DM || ws_size < WS_END) { fprintf(stderr, "kernel_launch: unexpected shapes n_in %d out %d ws %zu\n", n_in, out_size, ws_size); return; }
    Params P{};
    P.x = (const float*)d_in[0]; P.g_mix = (const float*)d_in[1]; P.w_in = (const float*)d_in[2]; P.b_f = (const float*)d_in[3];
    P.lq1 = (const float*)d_in[4]; P.lk1 = (const float*)d_in[5]; P.lq2 = (const float*)d_in[6]; P.lk2 = (const float*)d_in[7];
    P.g_subln = (const float*)d_in[8]; P.w_pa = (const float*)d_in[9]; P.w_pb = (const float*)d_in[10]; P.w_o = (const float*)d_in[11];
    P.g_mlp = (const float*)d_in[12]; P.w_1 = (const float*)d_in[13]; P.w_2 = (const float*)d_in[14]; P.rel_table = (const float*)d_in[15]; P.g_final = (const float*)d_in[16];
    P.out = (float*)d_out; P.ws = (unsigned char*)d_ws;
#if ONE_LAUNCH
    static int grid_blocks = 0;
    if (!grid_blocks) { int dev = 0, cus = 0, per_cu = 0; hipGetDevice(&dev); hipDeviceGetAttribute(&cus, hipDeviceAttributeMultiprocessorCount, dev);
        hipOccupancyMaxActiveBlocksPerMultiprocessor(&per_cu, fwd_mega, 256, 0); if (per_cu > 4) per_cu = 4; grid_blocks = cus * per_cu; }
    void* args[] = {&P};
    hipError_t e = hipLaunchCooperativeKernel((void*)fwd_mega, dim3(grid_blocks), dim3(256), args, 0, stream);
    if (e != hipSuccess) fprintf(stderr, "cooperative launch failed: %s (grid %d)\n", hipGetErrorString(e), grid_blocks);
#else
    for (int ph = 0; ph < NPHASE; ++ph) hipLaunchKernelGGL(fwd_phase, dim3(2048), dim3(256), 0, stream, P, ph);
#endif
}
```

```cpp
#include <hip/hip_runtime.h>
#include <hip/hip_cooperative_groups.h>
#include <cstdio>
#include <cstdint>
namespace cg = cooperative_groups;

#ifndef ONE_LAUNCH
#define ONE_LAUNCH 1
#endif

typedef unsigned short bf16_t;
typedef short bf16x8 __attribute__((ext_vector_type(8)));
typedef float f32x4 __attribute__((ext_vector_type(4)));
typedef float f32x16 __attribute__((ext_vector_type(16)));

constexpr int BATCH = 16, SEQ = 2048, DM = 1024, M = BATCH * SEQ, INC = 5128, NP = 5120, FF = 4096;
constexpr float EPS = 1e-6f, LOG2E = 1.4426950408889634f, C2 = 0.125f * LOG2E;
constexpr int C_DQ = 0, C_DK = 512, C_DV = 1024, C_FQ = 1536, C_FK = 2048, C_FV = 2560, C_G0 = 3072, C_G1 = 4096;
constexpr int C_OD = 0, C_MRG = 512, C_OF = 1536, C_T1 = 2048;

constexpr size_t MiB = 1u << 20;
constexpr size_t WS_WIN = 0, WS_WPA = 10 * MiB, WS_WPB = 11 * MiB, WS_WO = 12 * MiB, WS_W1 = 14 * MiB, WS_W2 = 22 * MiB;
constexpr size_t WS_LOGF = 30 * MiB, WS_FC = 31 * MiB, WS_BT = 32 * MiB, WS_XN = 34 * MiB, WS_PROJ = 98 * MiB, WS_END = 418 * MiB;

struct Params {
    const float* x; const float* g_mix; const float* w_in; const float* b_f; const float* lq1; const float* lk1; const float* lq2; const float* lk2;
    const float* g_subln; const float* w_pa; const float* w_pb; const float* w_o; const float* g_mlp; const float* w_1; const float* w_2; const float* rel_table; const float* g_final;
    float* out; unsigned char* ws;
};

__device__ __forceinline__ unsigned f2bf(float f) { unsigned u = __builtin_bit_cast(unsigned, f); return (u + 0x7fffu + ((u >> 16) & 1u)) >> 16; }
__device__ __forceinline__ unsigned pk2(float lo, float hi) { return f2bf(lo) | (f2bf(hi) << 16); }
__device__ __forceinline__ float bf2f(bf16_t b) { return __builtin_bit_cast(float, (unsigned)b << 16); }
__device__ __forceinline__ float wave_sum(float v) {
#pragma unroll
    for (int o = 1; o < 64; o <<= 1) v += __shfl_xor(v, o);
    return v;
}
__device__ __forceinline__ int crow(int r, int hi) { return (r & 3) + 8 * (r >> 2) + 4 * hi; }

__device__ __forceinline__ void transpose_item(const float* W, int ldw, int K, bf16_t* WT, float* scr, int kb, int nb, int lane) {
    const int k0 = 64 * kb, n0 = 32 * nb;
#pragma unroll 8
    for (int i = 0; i < 32; ++i) { const int kk = 2 * i + (lane >> 5); scr[kk * 33 + (lane & 31)] = W[(size_t)(k0 + kk) * ldw + n0 + (lane & 31)]; }
    __builtin_amdgcn_fence(__ATOMIC_RELEASE, "wavefront"); __builtin_amdgcn_wave_barrier(); __builtin_amdgcn_fence(__ATOMIC_ACQUIRE, "wavefront");
    const int c = lane & 7;
#pragma unroll
    for (int j = 0; j < 4; ++j) { const int n = (lane >> 3) + 8 * j; const float* s = scr + (8 * c) * 33 + n;
        uint4 o; o.x = pk2(s[0 * 33], s[1 * 33]); o.y = pk2(s[2 * 33], s[3 * 33]); o.z = pk2(s[4 * 33], s[5 * 33]); o.w = pk2(s[6 * 33], s[7 * 33]);
        *(uint4*)(WT + (size_t)(n0 + n) * K + k0 + 8 * c) = o; }
    __builtin_amdgcn_fence(__ATOMIC_RELEASE, "wavefront"); __builtin_amdgcn_wave_barrier(); __builtin_amdgcn_fence(__ATOMIC_ACQUIRE, "wavefront");
}

__device__ __forceinline__ int rel_bucket(int rel) {
    const int ret = rel > 0 ? 16 : 0; const int n = rel < 0 ? -rel : rel;
    int v;
    if (n < 8) v = n; else { int lg = (31 - __clz(n * n)) - 6; v = 8 + lg; if (v > 15) v = 15; }
    return ret + v;
}

__device__ __forceinline__ void norm_row(const float* xrow, const float* g, bf16_t* orow, const float* wfl  , const float* b_f, float* logf_row, int lane) {
    f32x4 v[4]; float s = 0.f;
#pragma unroll
    for (int j = 0; j < 4; ++j) { v[j] = *(const f32x4*)(xrow + 4 * lane + 256 * j); s += (v[j].x * v[j].x + v[j].y * v[j].y) + (v[j].z * v[j].z + v[j].w * v[j].w); }
    const float r = 1.0f / sqrtf(wave_sum(s) * (1.f / DM) + EPS);
    float fl[8];
#pragma unroll
    for (int h = 0; h < 8; ++h) fl[h] = 0.f;
#pragma unroll
    for (int j = 0; j < 4; ++j) {
        const f32x4 gg = *(const f32x4*)(g + 4 * lane + 256 * j);
        f32x4 y; y.x = v[j].x * r * gg.x; y.y = v[j].y * r * gg.y; y.z = v[j].z * r * gg.z; y.w = v[j].w * r * gg.w;
        uint2 o; o.x = pk2(y.x, y.y); o.y = pk2(y.z, y.w);
        *(uint2*)(orow + 4 * lane + 256 * j) = o;
        if (wfl) {
#pragma unroll
            for (int e = 0; e < 4; ++e) { const int k = 4 * lane + 256 * j + e; const float yy = y[e];
                const f32x4 w0 = *(const f32x4*)(wfl + (size_t)k * INC), w1 = *(const f32x4*)(wfl + (size_t)k * INC + 4);
                fl[0] += yy * w0.x; fl[1] += yy * w0.y; fl[2] += yy * w0.z; fl[3] += yy * w0.w; fl[4] += yy * w1.x; fl[5] += yy * w1.y; fl[6] += yy * w1.z; fl[7] += yy * w1.w; }
        }
    }
    if (wfl) {
#pragma unroll
        for (int h = 0; h < 8; ++h) fl[h] = wave_sum(fl[h]);
        if (lane < 8) { float z = 0.f;
#pragma unroll
            for (int h = 0; h < 8; ++h) if (lane == h) z = fl[h];
            z += b_f[lane];
            const float ls = fminf(z, 0.f) - log1pf(expf(-fabsf(z)));
            logf_row[lane] = ls; }
    }
}

__device__ void phase_prologue(const Params& P, float* lds, int bid, int nblk) {
    const int tid = threadIdx.x, lane = tid & 63, wave = tid >> 6, nw = blockDim.x >> 6;
    const int gw = bid * nw + wave, NGW = nblk * nw;
    float* scr = lds + wave * (64 * 33);
    unsigned char* ws = P.ws;
    constexpr int I_INA = 16 * 96, I_INB = 16 * 64, I_PA = 8 * 32, I_PB = 8 * 32, I_O = 16 * 32, I_1 = 16 * 128, I_2 = 64 * 32;
    constexpr int NITEMS = I_INA + I_INB + I_PA + I_PB + I_O + I_1 + I_2;
    for (int it = gw; it < NITEMS; it += NGW) {
        int r = it;
        if (r < I_INA) { transpose_item(P.w_in, INC, 1024, (bf16_t*)(ws + WS_WIN), scr, r / 96, r % 96, lane); continue; } r -= I_INA;
        if (r < I_INB) { transpose_item(P.w_in + 3080, INC, 1024, (bf16_t*)(ws + WS_WIN) + (size_t)3072 * 1024, scr, r / 64, r % 64, lane); continue; } r -= I_INB;
        if (r < I_PA) { transpose_item(P.w_pa, 1024, 512, (bf16_t*)(ws + WS_WPA), scr, r / 32, r % 32, lane); continue; } r -= I_PA;
        if (r < I_PB) { transpose_item(P.w_pb, 1024, 512, (bf16_t*)(ws + WS_WPB), scr, r / 32, r % 32, lane); continue; } r -= I_PB;
        if (r < I_O) { transpose_item(P.w_o, 1024, 1024, (bf16_t*)(ws + WS_WO), scr, r / 32, r % 32, lane); continue; } r -= I_O;
        if (r < I_1) { transpose_item(P.w_1, 4096, 1024, (bf16_t*)(ws + WS_W1), scr, r / 128, r % 128, lane); continue; } r -= I_1;
        transpose_item(P.w_2, 1024, 4096, (bf16_t*)(ws + WS_W2), scr, r / 32, r % 32, lane);
    }
    if (bid == 0) {
        float* BT = (float*)(ws + WS_BT);
        for (int i = tid; i < 4 * 256; i += blockDim.x) { const int h = i >> 8, rel = (i & 255) - 192;
            BT[i] = (P.rel_table[rel_bucket(rel) * 4 + h] - P.rel_table[15 * 4 + h]) * LOG2E; }
    }
    for (int m = gw; m < M; m += NGW)
        norm_row(P.x + (size_t)m * DM, P.g_mix, (bf16_t*)(ws + WS_XN) + (size_t)m * DM, P.w_in + 3072, P.b_f, (float*)(ws + WS_LOGF) + (size_t)m * 8, lane);
}

__device__ void phase_cumsum(const Params& P, int bid, int nblk) {
    const int tid = threadIdx.x, lane = tid & 63, wave = tid >> 6, nw = blockDim.x >> 6;
    const int gw = bid * nw + wave, NGW = nblk * nw;
    const float* LF = (const float*)(P.ws + WS_LOGF); float* FC = (float*)(P.ws + WS_FC);
    for (int seq = gw; seq < BATCH * 8; seq += NGW) {
        const int b = seq >> 3, h = seq & 7;
        const size_t base = ((size_t)b * SEQ + lane * 32) * 8 + h;
        float loc[32]; float run = 0.f;
#pragma unroll
        for (int i = 0; i < 32; ++i) { run += LF[base + (size_t)i * 8]; loc[i] = run; }
        float incl = run;
#pragma unroll
        for (int o = 1; o < 64; o <<= 1) { const float t = __shfl_up(incl, o); if (lane >= o) incl += t; }
        const float excl = incl - run;
#pragma unroll
        for (int i = 0; i < 32; ++i) FC[base + (size_t)i * 8] = (loc[i] + excl) * LOG2E;
    }
}

template <class Epi>
__device__ void gemm_simple(const bf16_t* A, int lda, const bf16_t* Bt, int ldb, int Mr, int N, int K, const Epi& epi, unsigned char* smem, int bid, int nblk) {
    constexpr int LP = 40;
    bf16_t* sA = (bf16_t*)smem; bf16_t* sB = sA + 128 * LP;
    const int tid = threadIdx.x, lane = tid & 63, wave = tid >> 6, wr = wave >> 1, wc = wave & 1, r32 = lane & 31, hi = lane >> 5;
    const int tilesN = N / 128, tiles = (Mr / 128) * tilesN;
    for (int t = bid; t < tiles; t += nblk) {
        const int m0 = (t / tilesN) * 128, n0 = (t % tilesN) * 128;
        f32x16 acc[2][2];
#pragma unroll
        for (int i = 0; i < 2; ++i)
#pragma unroll
            for (int j = 0; j < 2; ++j) acc[i][j] = f32x16{};
        for (int k0 = 0; k0 < K; k0 += 32) {
            __syncthreads();
#pragma unroll
            for (int i = 0; i < 2; ++i) { const int row = (tid >> 2) + 64 * i, ch = tid & 3;
                *(uint4*)(sA + row * LP + ch * 8) = *(const uint4*)(A + (size_t)(m0 + row) * lda + k0 + ch * 8);
                *(uint4*)(sB + row * LP + ch * 8) = *(const uint4*)(Bt + (size_t)(n0 + row) * ldb + k0 + ch * 8); }
            __syncthreads();
#pragma unroll
            for (int kk = 0; kk < 2; ++kk) {
                bf16x8 a[2], b[2];
#pragma unroll
                for (int i = 0; i < 2; ++i) { a[i] = *(const bf16x8*)(sA + (wr * 64 + i * 32 + r32) * LP + kk * 16 + hi * 8); b[i] = *(const bf16x8*)(sB + (wc * 64 + i * 32 + r32) * LP + kk * 16 + hi * 8); }
#pragma unroll
                for (int i = 0; i < 2; ++i)
#pragma unroll
                    for (int j = 0; j < 2; ++j) acc[i][j] = __builtin_amdgcn_mfma_f32_32x32x16_bf16(a[i], b[j], acc[i][j], 0, 0, 0);
            }
        }
#pragma unroll
        for (int i = 0; i < 2; ++i)
#pragma unroll
            for (int j = 0; j < 2; ++j)
#pragma unroll
                for (int r = 0; r < 16; ++r) epi(m0 + wr * 64 + i * 32 + crow(r, hi), n0 + wc * 64 + j * 32 + r32, acc[i][j][r]);
    }
}

struct EpiProj { bf16_t* PROJ;
    __device__ __forceinline__ void operator()(int row, int col, float v) const {
        float o;
        if (col < C_G0) { const bool isq = (col < 512) || (col >= C_FQ && col < C_FK); o = isq ? v * C2 : v; }
        else o = 1.0f / (1.0f + __expf(-v));
        PROJ[(size_t)row * NP + col] = (bf16_t)f2bf(o); } };
struct EpiT1 { bf16_t* PROJ;
    __device__ __forceinline__ void operator()(int row, int col, float v) const { bf16_t* p = PROJ + (size_t)row * NP; p[C_T1 + col] = (bf16_t)f2bf(v * bf2f(p[C_G0 + col])); } };
struct EpiMrg { bf16_t* PROJ;
    __device__ __forceinline__ void operator()(int row, int col, float v) const { bf16_t* p = PROJ + (size_t)row * NP; p[C_MRG + col] = (bf16_t)f2bf(bf2f(p[C_T1 + col]) + v * bf2f(p[C_G1 + col])); } };
struct EpiX1 { const float* x; float* out;
    __device__ __forceinline__ void operator()(int row, int col, float v) const { const size_t i = (size_t)row * DM + col; out[i] = x[i] + v; } };
struct EpiUp { bf16_t* HH;
    __device__ __forceinline__ void operator()(int row, int col, float v) const { const float t = fmaxf(v, 0.f); HH[(size_t)row * FF + col] = (bf16_t)f2bf(t * t); } };
struct EpiDown { float* out;
    __device__ __forceinline__ void operator()(int row, int col, float v) const { const size_t i = (size_t)row * DM + col; out[i] += v; } };

template <int MODE>
__device__ void attn_wave(const bf16_t* Qp, const bf16_t* Kp, const bf16_t* Vp, bf16_t* Op, int opitch, int q0, const float* fc  , const float* bt, int lane) {
    constexpr int NDB = MODE == 0 ? 2 : 4;
    const int r32 = lane & 31, hi = lane >> 5;
    bf16x8 qr[4];
#pragma unroll
    for (int d0 = 0; d0 < 4; ++d0) qr[d0] = *(const bf16x8*)(Qp + (size_t)(q0 + r32) * NP + d0 * 16 + hi * 8);
    f32x16 o[NDB];
#pragma unroll
    for (int d = 0; d < NDB; ++d) o[d] = f32x16{};
    float mrun = -INFINITY, lrun = 0.f;
    const int q = q0 + r32;
    const int kend = MODE == 0 ? q0 + 32 : ((q0 >> 6) + 1) * 64;
    for (int kv0 = 0; kv0 < kend; kv0 += 32) {
        f32x16 s = f32x16{};
#pragma unroll
        for (int d0 = 0; d0 < 4; ++d0) { const bf16x8 kf = *(const bf16x8*)(Kp + (size_t)(kv0 + r32) * NP + d0 * 16 + hi * 8);
            s = __builtin_amdgcn_mfma_f32_32x32x16_bf16(kf, qr[d0], s, 0, 0, 0); }
        float tmax = -INFINITY;
#pragma unroll
        for (int r = 0; r < 16; ++r) { const int kv = kv0 + crow(r, hi);
            if (MODE == 0) { s[r] = (kv > q) ? -INFINITY : s[r] - fc[(size_t)kv * 8]; }
            else { int rel = kv - q; if (rel < -192) rel = -192; s[r] += bt[rel + 192]; }
            tmax = fmaxf(tmax, s[r]); }
        tmax = fmaxf(tmax, __shfl_xor(tmax, 32));
        const float mnew = fmaxf(mrun, tmax);
        const float alpha = exp2f(mrun - mnew);
        mrun = mnew;
        float psum = 0.f;
#pragma unroll
        for (int r = 0; r < 16; ++r) { s[r] = exp2f(s[r] - mnew); psum += s[r]; }
        lrun = lrun * alpha + psum;
#pragma unroll
        for (int r = 0; r < 16; ++r) { const float a = __shfl(alpha, crow(r, hi));
#pragma unroll
            for (int d = 0; d < NDB; ++d) o[d][r] *= a; }
#pragma unroll
        for (int st = 0; st < 2; ++st) {
            bf16x8 pa;
#pragma unroll
            for (int j = 0; j < 8; ++j) pa[j] = (short)f2bf(s[8 * st + j]);
#pragma unroll
            for (int d = 0; d < NDB; ++d) {
                bf16x8 vb;
#pragma unroll
                for (int j = 0; j < 8; ++j) { const int kv = kv0 + 16 * st + 8 * (j >> 2) + 4 * hi + (j & 3); vb[j] = (short)Vp[(size_t)kv * NP + d * 32 + r32]; }
                o[d] = __builtin_amdgcn_mfma_f32_32x32x16_bf16(pa, vb, o[d], 0, 0, 0);
            }
        }
    }
    const float ltot = lrun + __shfl_xor(lrun, 32);
    const float linv = 1.0f / ltot;
#pragma unroll
    for (int r = 0; r < 16; ++r) { const int qr_ = crow(r, hi); const float li = __shfl(linv, qr_);
#pragma unroll
        for (int d = 0; d < NDB; ++d) Op[(size_t)(q0 + qr_) * opitch + d * 32 + r32] = (bf16_t)f2bf(o[d][r] * li); }
}

__device__ void phase_attention(const Params& P, int bid, int nblk) {
    const int tid = threadIdx.x, lane = tid & 63, wave = tid >> 6, nw = blockDim.x >> 6;
    const int gw = bid * nw + wave, NGW = nblk * nw;
    bf16_t* PROJ = (bf16_t*)(P.ws + WS_PROJ); bf16_t* ODRAW = (bf16_t*)(P.ws + WS_XN);
    const float* FC = (const float*)(P.ws + WS_FC); const float* BT = (const float*)(P.ws + WS_BT);
    const int NIT = 64 * BATCH * 16;
    for (int it = gw; it < NIT; it += NGW) {
        const int qb = 63 - it / (BATCH * 16), rem = it % (BATCH * 16), b = rem >> 4, vh = rem & 15;
        const size_t rb = (size_t)b * SEQ;
        if (vh < 8) {
            const int h = vh; bf16_t* base = PROJ + rb * NP;
            attn_wave<0>(base + C_FQ + h * 64, base + C_FK + h * 64, base + C_FV + h * 64, base + C_OF + h * 64, NP, qb * 32, FC + rb * 8 + h, nullptr, lane);
        } else {
            const int h = (vh - 8) >> 1, mp = (vh - 8) & 1; bf16_t* base = PROJ + rb * NP;
            attn_wave<1>(base + C_DQ + h * 128 + mp * 64, base + C_DK + h * 128 + mp * 64, base + C_DV + h * 128, ODRAW + rb * 1024 + h * 256 + mp * 128, 1024, qb * 32, nullptr, BT + h * 256, lane);
        }
    }
}

__device__ void phase_combine(const Params& P, int bid, int nblk) {
    const int tid = threadIdx.x, lane = tid & 63, wave = tid >> 6, nw = blockDim.x >> 6;
    const int gw = bid * nw + wave, NGW = nblk * nw;
    const float s1 = wave_sum(P.lq1[lane] * P.lk1[lane]), s2 = wave_sum(P.lq2[lane] * P.lk2[lane]);
    const float lam = expf(s1) - expf(s2) + 0.2f;
    bf16_t* PROJ = (bf16_t*)(P.ws + WS_PROJ); const bf16_t* ODRAW = (const bf16_t*)(P.ws + WS_XN);
    const int h = lane >> 4, e0 = (lane & 15) * 8;
    float g[8];
#pragma unroll
    for (int j = 0; j < 8; ++j) g[j] = P.g_subln[e0 + j] * 0.8f;
    for (int m = gw; m < M; m += NGW) {
        const bf16x8 a = *(const bf16x8*)(ODRAW + (size_t)m * 1024 + h * 256 + e0), b = *(const bf16x8*)(ODRAW + (size_t)m * 1024 + h * 256 + 128 + e0);
        float v[8]; float ss = 0.f;
#pragma unroll
        for (int j = 0; j < 8; ++j) { v[j] = bf2f((bf16_t)a[j]) - lam * bf2f((bf16_t)b[j]); ss += v[j] * v[j]; }
        ss += __shfl_xor(ss, 1); ss += __shfl_xor(ss, 2); ss += __shfl_xor(ss, 4); ss += __shfl_xor(ss, 8);
        const float r = 1.0f / sqrtf(ss * (1.f / 128.f) + EPS);
        uint4 o; o.x = pk2(v[0] * r * g[0], v[1] * r * g[1]); o.y = pk2(v[2] * r * g[2], v[3] * r * g[3]); o.z = pk2(v[4] * r * g[4], v[5] * r * g[5]); o.w = pk2(v[6] * r * g[6], v[7] * r * g[7]);
        *(uint4*)(PROJ + (size_t)m * NP + C_OD + h * 128 + e0) = o;
    }
}

__device__ void phase_norm2(const Params& P, int bid, int nblk) {
    const int tid = threadIdx.x, lane = tid & 63, wave = tid >> 6, nw = blockDim.x >> 6;
    const int gw = bid * nw + wave, NGW = nblk * nw;
    for (int m = gw; m < M; m += NGW) norm_row(P.out + (size_t)m * DM, P.g_mlp, (bf16_t*)(P.ws + WS_XN) + (size_t)m * DM, nullptr, nullptr, nullptr, lane);
}
__device__ void phase_final(const Params& P, int bid, int nblk) {
    const int tid = threadIdx.x, lane = tid & 63, wave = tid >> 6, nw = blockDim.x >> 6;
    const int gw = bid * nw + wave, NGW = nblk * nw;
    for (int m = gw; m < M; m += NGW) {
        float* row = P.out + (size_t)m * DM; f32x4 v[4]; float s = 0.f;
#pragma unroll
        for (int j = 0; j < 4; ++j) { v[j] = *(const f32x4*)(row + 4 * lane + 256 * j); s += (v[j].x * v[j].x + v[j].y * v[j].y) + (v[j].z * v[j].z + v[j].w * v[j].w); }
        const float r = 1.0f / sqrtf(wave_sum(s) * (1.f / DM) + EPS);
#pragma unroll
        for (int j = 0; j < 4; ++j) { const f32x4 gg = *(const f32x4*)(P.g_final + 4 * lane + 256 * j); f32x4 y; y.x = v[j].x * r * gg.x; y.y = v[j].y * r * gg.y; y.z = v[j].z * r * gg.z; y.w = v[j].w * r * gg.w;
            *(f32x4*)(row + 4 * lane + 256 * j) = y; }
    }
}

constexpr int NPHASE = 11;
__device__ __forceinline__ void run_phase(const Params& P, int ph, unsigned char* smem, int bid, int nblk) {
    bf16_t* PROJ = (bf16_t*)(P.ws + WS_PROJ);
    switch (ph) {
    case 0: phase_prologue(P, (float*)smem, bid, nblk); break;
    case 1: phase_cumsum(P, bid, nblk);
            gemm_simple((const bf16_t*)(P.ws + WS_XN), DM, (const bf16_t*)(P.ws + WS_WIN), 1024, M, NP, 1024, EpiProj{PROJ}, smem, bid, nblk); break;
    case 2: phase_attention(P, bid, nblk); break;
    case 3: phase_combine(P, bid, nblk); break;
    case 4: gemm_simple(PROJ + C_OD, NP, (const bf16_t*)(P.ws + WS_WPA), 512, M, 1024, 512, EpiT1{PROJ}, smem, bid, nblk); break;
    case 5: gemm_simple(PROJ + C_OF, NP, (const bf16_t*)(P.ws + WS_WPB), 512, M, 1024, 512, EpiMrg{PROJ}, smem, bid, nblk); break;
    case 6: gemm_simple(PROJ + C_MRG, NP, (const bf16_t*)(P.ws + WS_WO), 1024, M, 1024, 1024, EpiX1{P.x, P.out}, smem, bid, nblk); break;
    case 7: phase_norm2(P, bid, nblk); break;
    case 8: gemm_simple((const bf16_t*)(P.ws + WS_XN), DM, (const bf16_t*)(P.ws + WS_W1), 1024, M, FF, 1024, EpiUp{PROJ}, smem, bid, nblk); break;
    case 9: gemm_simple(PROJ, FF, (const bf16_t*)(P.ws + WS_W2), 4096, M, 1024, 4096, EpiDown{P.out}, smem, bid, nblk); break;
    case 10: phase_final(P, bid, nblk); break;
    }
}

constexpr int SMEM_BYTES = 4 * 64 * 33 * 4;

#if ONE_LAUNCH
__global__ void __launch_bounds__(256) fwd_mega(Params P) {
    __shared__ __attribute__((aligned(16))) unsigned char smem[SMEM_BYTES];
    cg::grid_group grid = cg::this_grid();
    for (int ph = 0; ph < NPHASE; ++ph) { run_phase(P, ph, smem, blockIdx.x, gridDim.x); if (ph + 1 < NPHASE) grid.sync(); }
}
#else
__global__ void __launch_bounds__(256) fwd_phase(Params P, int ph) {
    __shared__ __attribute__((aligned(16))) unsigned char smem[SMEM_BYTES];
    run_phase(P, ph, smem, blockIdx.x, gridDim.x);
}
#endif

extern "C" void kernel_launch(void* const* d_in, const int* in_sizes, int n_in, void* d_out, int out_size, void* d_ws, size_t ws_size, hipStream_t stream) {
    if (n_in != 17 || out_size != M * DM || ws_size < WS_END) { fprintf(stderr, "kernel_launch: unexpected shapes n_in %d out %d ws %zu\n", n_in, out_size, ws_size); return; }
    Params P{};
    P.x = (const float*)d_in[0]; P.g_mix = (const float*)d_in[1]; P.w_in = (const float*)d_in[2]; P.b_f = (const float*)d_in[3];
    P.lq1 = (const float*)d_in[4]; P.lk1 = (const float*)d_in[5]; P.lq2 = (const float*)d_in[6]; P.lk2 = (const float*)d_in[7];
    P.g_subln = (const float*)d_in[8]; P.w_pa = (const float*)d_in[9]; P.w_pb = (const float*)d_in[10]; P.w_o = (const float*)d_in[11];
    P.g_mlp = (const float*)d_in[12]; P.w_1 = (const float*)d_in[13]; P.w_2 = (const float*)d_in[14]; P.rel_table = (const float*)d_in[15]; P.g_final = (const float*)d_in[16];
    P.out = (float*)d_out; P.ws = (unsigned char*)d_ws;
#if ONE_LAUNCH
    static int grid_blocks = 0;
    if (!grid_blocks) { int dev = 0, cus = 0, per_cu = 0; hipGetDevice(&dev); hipDeviceGetAttribute(&cus, hipDeviceAttributeMultiprocessorCount, dev);
        hipOccupancyMaxActiveBlocksPerMultiprocessor(&per_cu, fwd_mega, 256, 0); if (per_cu > 4) per_cu = 4; grid_blocks = cus * per_cu; }
    void* args[] = {&P};
    hipError_t e = hipLaunchCooperativeKernel((void*)fwd_mega, dim3(grid_blocks), dim3(256), args, 0, stream);
    if (e != hipSuccess) fprintf(stderr, "cooperative launch failed: %s (grid %d)\n", hipGetErrorString(e), grid_blocks);
#else
    for (int ph = 0; ph < NPHASE; ++ph) hipLaunchKernelGGL(fwd_phase, dim3(2048), dim3(256), 0, stream, P, ph);
#endif
}
```

```cpp
#include <hip/hip_runtime.h>
#include <hip/hip_cooperative_groups.h>
#include <cstdio>
#include <cstdint>
namespace cg = cooperative_groups;
namespace pg8 {
#define PG8_LAS __attribute__((address_space(3)))
typedef unsigned short bf16_t;
typedef short bf16x8 __attribute__((ext_vector_type(8)));
typedef float f32x4 __attribute__((ext_vector_type(4)));
typedef unsigned u32x4 __attribute__((ext_vector_type(4)));
constexpr int BM = 256, BK = 64, HALF = 128, HTB = HALF * BK * 2  , STAGE_BYTES = 8 * HTB, NXCD = 8, WGM = 8;

__host__ __device__ __forceinline__ int lds_byte(int r, int c) { const int st = (r >> 4) * 2 + (c >> 5), rr = r & 15, cc = c & 31, ob = rr * 64 + cc * 2; return st * 1024 + (ob ^ (((ob >> 9) & 1) << 5)); }
__host__ __device__ __forceinline__ void stage_rc(int b, int& R, int& C) { const int st = b / 1024, sb = b % 1024, swz = sb ^ (((sb >> 9) & 1) << 5); R = (st >> 1) * 16 + swz / 64; C = (st & 1) * 32 + (swz % 64) / 2; }
__host__ __device__ __forceinline__ int perm32(int rho) { const int n = rho >> 4, i = rho & 15; return 8 * (i >> 2) + 4 * n + (i & 3); }

struct Unit { int pm, pn; };
struct Gemm { const bf16_t* A; const bf16_t* Bt; int M, N, K, lda, ldb; };

struct StaticOrder {
    int nM, nN, nwg, G, c;
    __host__ __device__ void init(int M, int N, int G_, int c_) { nM = M / BM; nN = N / BM; nwg = nM * nN; G = G_; c = c_; }
    __host__ __device__ bool next(int i, Unit& u) const {
        const long L = (long)i * G + c; if (L >= nwg) return false;
        int wgid = (int)L; { const int q = nwg / NXCD, r = nwg % NXCD, xcd = wgid % NXCD, off = wgid / NXCD; wgid = (xcd < r ? xcd * (q + 1) : r * (q + 1) + (xcd - r) * q) + off; }
        const int nig = WGM * nN, gid = wgid / nig, fm = gid * WGM, gsz = (nM - fm) < WGM ? (nM - fm) : WGM;
        u.pm = fm + ((wgid % nig) % gsz); u.pn = (wgid % nig) / gsz; return true;
    }
    __device__ __forceinline__ void a_ready(const Unit&) const {}
    __device__ __forceinline__ void done(const Unit&) const {}
};


__device__ __forceinline__ unsigned cvt_pk_bf16(float lo, float hi) { unsigned r; asm volatile("v_cvt_pk_bf16_f32 %0, %1, %2" : "=v"(r) : "v"(lo), "v"(hi)); return r; }
__device__ __forceinline__ float bflo(unsigned w) { return __builtin_bit_cast(float, w << 16); }
__device__ __forceinline__ float bfhi(unsigned w) { return __builtin_bit_cast(float, w & 0xffff0000u); }
constexpr int PROJ_LD = 5120;
constexpr float EPI_C2 = 0.125f * 1.4426950408889634f;
struct EpiProj {
    static constexpr bool PERM = true, AFTER_DRAIN = false;
    bf16_t* O;
    __device__ __forceinline__ void operator()(const f32x4 (&acc)[2][2][4][2], const Unit& u, int wr, int wc, int fr, int fq) const {
        const int row0 = u.pm * BM + wr * 64 + fr, col0 = u.pn * BM + wc * 32 + 8 * fq;
        const bool gate = u.pn >= 12; const float sc = (u.pn < 2 || (u.pn >= 6 && u.pn < 8)) ? EPI_C2 : 1.0f;
#pragma unroll
        for (int ai = 0; ai < 2; ++ai)
#pragma unroll
            for (int m = 0; m < 4; ++m) { bf16_t* rowp = O + (size_t)(row0 + ai * HALF + m * 16) * PROJ_LD + col0;
#pragma unroll
                for (int bj = 0; bj < 2; ++bj) { f32x4 v0 = acc[ai][bj][m][0], v1 = acc[ai][bj][m][1];
                    if (gate) {
#pragma unroll
                        for (int e = 0; e < 4; ++e) { v0[e] = __builtin_amdgcn_rcpf(1.0f + __expf(-v0[e])); v1[e] = __builtin_amdgcn_rcpf(1.0f + __expf(-v1[e])); }
                    } else { v0 = v0 * sc; v1 = v1 * sc; }
                    u32x4 w; w.x = cvt_pk_bf16(v0[0], v0[1]); w.y = cvt_pk_bf16(v0[2], v0[3]); w.z = cvt_pk_bf16(v1[0], v1[1]); w.w = cvt_pk_bf16(v1[2], v1[3]);
                    *(u32x4*)(rowp + bj * HALF) = w; } }
    }
};
struct EpiGate {
    static constexpr bool PERM = true, AFTER_DRAIN = false;
    bf16_t* P; int c_gate, c_add, c_out;
    __device__ __forceinline__ void operator()(const f32x4 (&acc)[2][2][4][2], const Unit& u, int wr, int wc, int fr, int fq) const {
        const int row0 = u.pm * BM + wr * 64 + fr, col0 = u.pn * BM + wc * 32 + 8 * fq;
#pragma unroll
        for (int ai = 0; ai < 2; ++ai)
#pragma unroll
            for (int m = 0; m < 4; ++m) { bf16_t* rowp = P + (size_t)(row0 + ai * HALF + m * 16) * PROJ_LD + col0;
#pragma unroll
                for (int bj = 0; bj < 2; ++bj) { const f32x4 v0 = acc[ai][bj][m][0], v1 = acc[ai][bj][m][1];
                    const u32x4 g = *(const u32x4*)(rowp + c_gate + bj * HALF);
                    float o[8] = {v0[0] * bflo(g.x), v0[1] * bfhi(g.x), v0[2] * bflo(g.y), v0[3] * bfhi(g.y), v1[0] * bflo(g.z), v1[1] * bfhi(g.z), v1[2] * bflo(g.w), v1[3] * bfhi(g.w)};
                    if (c_add >= 0) { const u32x4 a = *(const u32x4*)(rowp + c_add + bj * HALF);
                        o[0] += bflo(a.x); o[1] += bfhi(a.x); o[2] += bflo(a.y); o[3] += bfhi(a.y); o[4] += bflo(a.z); o[5] += bfhi(a.z); o[6] += bflo(a.w); o[7] += bfhi(a.w); }
                    u32x4 w; w.x = cvt_pk_bf16(o[0], o[1]); w.y = cvt_pk_bf16(o[2], o[3]); w.z = cvt_pk_bf16(o[4], o[5]); w.w = cvt_pk_bf16(o[6], o[7]);
                    *(u32x4*)(rowp + c_out + bj * HALF) = w; } }
    }
};
struct EpiResF32 {
    static constexpr bool PERM = false, AFTER_DRAIN = false;
    const float* base; float* out;
    __device__ __forceinline__ void operator()(const f32x4 (&acc)[2][2][4][2], const Unit& u, int wr, int wc, int fr, int fq) const {
        const int row0 = u.pm * BM + wr * 64 + fr, col0 = u.pn * BM + wc * 32 + 4 * fq;
#pragma unroll
        for (int ai = 0; ai < 2; ++ai)
#pragma unroll
            for (int m = 0; m < 4; ++m) { const size_t off = (size_t)(row0 + ai * HALF + m * 16) * 1024 + col0;
#pragma unroll
                for (int bj = 0; bj < 2; ++bj)
#pragma unroll
                    for (int n = 0; n < 2; ++n) { const f32x4 b = *(const f32x4*)(base + off + bj * HALF + n * 16); *(f32x4*)(out + off + bj * HALF + n * 16) = b + acc[ai][bj][m][n]; } }
    }
};
struct EpiRelu2 {
    static constexpr bool PERM = true, AFTER_DRAIN = false;
    bf16_t* O; int ldc;
    __device__ __forceinline__ void operator()(const f32x4 (&acc)[2][2][4][2], const Unit& u, int wr, int wc, int fr, int fq) const {
        const int row0 = u.pm * BM + wr * 64 + fr, col0 = u.pn * BM + wc * 32 + 8 * fq;
#pragma unroll
        for (int ai = 0; ai < 2; ++ai)
#pragma unroll
            for (int m = 0; m < 4; ++m) { bf16_t* rowp = O + (size_t)(row0 + ai * HALF + m * 16) * ldc + col0;
#pragma unroll
                for (int bj = 0; bj < 2; ++bj) { f32x4 v0 = acc[ai][bj][m][0], v1 = acc[ai][bj][m][1];
#pragma unroll
                    for (int e = 0; e < 4; ++e) { const float a = fmaxf(v0[e], 0.f), b = fmaxf(v1[e], 0.f); v0[e] = a * a; v1[e] = b * b; }
                    u32x4 w; w.x = cvt_pk_bf16(v0[0], v0[1]); w.y = cvt_pk_bf16(v0[2], v0[3]); w.z = cvt_pk_bf16(v1[0], v1[1]); w.w = cvt_pk_bf16(v1[2], v1[3]);
                    *(u32x4*)(rowp + bj * HALF) = w; } }
    }
};

template <class Epi, class Sched, bool ALIGN_EPI = false, bool SP2 = false>
__device__ __forceinline__ void gemm_phase(PG8_LAS unsigned char* lds, const Gemm g, const Sched& S, const Epi& E) {
    const int tid = threadIdx.x, wid = __builtin_amdgcn_readfirstlane(tid >> 6), lane = tid & 63, wr = wid >> 2, wc = wid & 3, fr = lane & 15, fq = lane >> 4;
    const int K = g.K, nt = K / BK;
    unsigned voffA[2], voffB[2];
#pragma unroll
    for (int i = 0; i < 2; ++i) { int R, C; stage_rc(tid * 16 + i * 8192, R, C); const int Rb = Epi::PERM ? ((R & ~31) + perm32(R & 31)) : R;
        voffA[i] = (unsigned)(R * g.lda + C) * 2u; voffB[i] = (unsigned)(Rb * g.ldb + C) * 2u; }
    const size_t kstep = (size_t)(BK * 2);
    const size_t hstepA = (size_t)HALF * g.lda * 2, hstepB = (size_t)HALF * g.ldb * 2;
    const size_t tstepA = 2 * hstepA, tstepB = 2 * hstepB;
    const unsigned ldsw = (unsigned)wid * 1024u;
    const int aoff = lds_byte(wr * 64 + fr, fq * 8), boff = lds_byte(wc * 32 + fr, fq * 8);
#define PG8_SA(b, h) (((b) * 2 + (h)) * HTB)
#define PG8_SB(b, h) ((4 + (b) * 2 + (h)) * HTB)
#define PG8_STAGE(bufoff, gbase, voff) do { _Pragma("unroll") for (int _i = 0; _i < 2; ++_i) \
        __builtin_amdgcn_global_load_lds((const unsigned*)((const char*)(gbase) + (voff)[_i]), (PG8_LAS unsigned*)(lds + (bufoff) + ldsw + _i * 8192), 16, 0, 0); } while (0)
#define PG8_LDA(dst, b, h) do { _Pragma("unroll") for (int m = 0; m < 4; ++m) _Pragma("unroll") for (int k = 0; k < 2; ++k) dst[m][k] = *(const PG8_LAS bf16x8*)(lds + PG8_SA(b, h) + aoff + m * 2048 + k * 1024); } while (0)
#define PG8_LDB(dst, b, h) do { _Pragma("unroll") for (int n = 0; n < 2; ++n) _Pragma("unroll") for (int k = 0; k < 2; ++k) dst[n][k] = *(const PG8_LAS bf16x8*)(lds + PG8_SB(b, h) + boff + n * 2048 + k * 1024); } while (0)
#define PG8_MMA(ai, bj, At, Bt) do { __builtin_amdgcn_s_setprio(1); _Pragma("unroll") for (int m = 0; m < 4; ++m) _Pragma("unroll") for (int n = 0; n < 2; ++n) _Pragma("unroll") for (int k = 0; k < 2; ++k) \
        acc[ai][bj][m][n] = __builtin_amdgcn_mfma_f32_16x16x32_bf16(Bt[n][k], At[m][k], acc[ai][bj][m][n], 0, 0, 0); __builtin_amdgcn_s_setprio(0); } while (0)
#define PG8_WAIT_V(n) asm volatile("s_waitcnt vmcnt(" #n ")" ::: "memory")
#define PG8_WAIT_L(n) asm volatile("s_waitcnt lgkmcnt(" #n ")" ::: "memory")
#define PG8_BAR __builtin_amdgcn_s_barrier()
#define PG8_SCHED __builtin_amdgcn_sched_barrier(0)
    Unit cur, nxt; int ui = 0;
    if (!S.next(0, cur)) return;
    f32x4 acc[2][2][4][2];
#pragma unroll
    for (int a = 0; a < 2; ++a)
#pragma unroll
        for (int b = 0; b < 2; ++b)
#pragma unroll
            for (int m = 0; m < 4; ++m)
#pragma unroll
                for (int n = 0; n < 2; ++n) acc[a][b][m][n] = (f32x4){0.f, 0.f, 0.f, 0.f};
    bf16x8 At[4][2], B0[2][2], B1[2][2];
    const char* cA = (const char*)g.A + (size_t)cur.pm * tstepA; const char* cB = (const char*)g.Bt + (size_t)cur.pn * tstepB;
    S.a_ready(cur);
    if constexpr (SP2) {
        PG8_STAGE(PG8_SB(0, 0), cB, voffB); PG8_STAGE(PG8_SB(0, 1), cB + hstepB, voffB); PG8_STAGE(PG8_SA(0, 0), cA, voffA); PG8_STAGE(PG8_SA(0, 1), cA + hstepA, voffA);
        if (wr == 1) PG8_BAR;
        PG8_WAIT_V(2); PG8_BAR;
        PG8_STAGE(PG8_SB(1, 0), cB + kstep, voffB); PG8_STAGE(PG8_SA(1, 0), cA + kstep, voffA); PG8_STAGE(PG8_SB(1, 1), cB + hstepB + kstep, voffB);
        PG8_WAIT_V(6); PG8_BAR;
    } else {
        PG8_STAGE(PG8_SB(0, 0), cB, voffB); PG8_STAGE(PG8_SA(0, 0), cA, voffA); PG8_STAGE(PG8_SB(0, 1), cB + hstepB, voffB); PG8_STAGE(PG8_SA(0, 1), cA + hstepA, voffA);
        if (wr == 1) PG8_BAR;
        PG8_WAIT_V(4); PG8_BAR;
        PG8_STAGE(PG8_SB(1, 0), cB + kstep, voffB); PG8_STAGE(PG8_SA(1, 0), cA + kstep, voffA); PG8_STAGE(PG8_SB(1, 1), cB + hstepB + kstep, voffB);
        PG8_WAIT_V(6); PG8_BAR;
    }
    for (;;) {
        const bool has_next = S.next(ui + 1, nxt);
        const char* nA = has_next ? (const char*)g.A + (size_t)nxt.pm * tstepA : cA; const char* nB = has_next ? (const char*)g.Bt + (size_t)nxt.pn * tstepB : cB;
        for (int t = 0; t < nt; t += 2) {
            const bool last = (t == nt - 2);
            const char* a1 = cA + (size_t)(t + 1) * kstep;
            const char* a2 = last ? nA : cA + (size_t)(t + 2) * kstep; const char* b2 = last ? nB : cB + (size_t)(t + 2) * kstep;
            const char* a3 = a2 + kstep; const char* b3 = b2 + kstep;
            if (last && has_next) S.a_ready(nxt);
            if constexpr (SP2) {
            PG8_LDB(B0, 0, 0); PG8_LDB(B1, 0, 1); PG8_SCHED; PG8_LDA(At, 0, 0); PG8_STAGE(PG8_SA(1, 1), a1 + hstepA, voffA);
            PG8_WAIT_V(8); PG8_WAIT_L(0); PG8_BAR; PG8_MMA(0, 0, At, B0); PG8_MMA(0, 1, At, B1); PG8_BAR; PG8_SCHED;
            PG8_LDA(At, 0, 1); PG8_STAGE(PG8_SB(0, 0), b2, voffB); PG8_STAGE(PG8_SB(0, 1), b2 + hstepB, voffB); PG8_STAGE(PG8_SA(0, 0), a2, voffA);
            PG8_WAIT_V(8); PG8_WAIT_L(0); PG8_BAR; PG8_MMA(1, 0, At, B0); PG8_MMA(1, 1, At, B1); PG8_BAR; PG8_SCHED;
            PG8_LDB(B0, 1, 0); PG8_LDB(B1, 1, 1); PG8_SCHED; PG8_LDA(At, 1, 0); PG8_STAGE(PG8_SA(0, 1), a2 + hstepA, voffA);
            PG8_WAIT_V(8); PG8_WAIT_L(0); PG8_BAR; PG8_MMA(0, 0, At, B0); PG8_MMA(0, 1, At, B1); PG8_BAR; PG8_SCHED;
            PG8_LDA(At, 1, 1); PG8_STAGE(PG8_SB(1, 0), b3, voffB); PG8_STAGE(PG8_SB(1, 1), b3 + hstepB, voffB); PG8_STAGE(PG8_SA(1, 0), a3, voffA);
            PG8_WAIT_V(8); PG8_WAIT_L(0); PG8_BAR; PG8_MMA(1, 0, At, B0); PG8_MMA(1, 1, At, B1); PG8_BAR; PG8_SCHED;
            } else {
            PG8_LDB(B0, 0, 0); PG8_SCHED; PG8_LDA(At, 0, 0); PG8_STAGE(PG8_SA(1, 1), a1 + hstepA, voffA);
            PG8_WAIT_L(8); PG8_BAR; PG8_WAIT_L(0); PG8_MMA(0, 0, At, B0); PG8_BAR; PG8_SCHED;
            PG8_LDB(B1, 0, 1); PG8_STAGE(PG8_SB(0, 0), b2, voffB);
            PG8_BAR; PG8_WAIT_L(0); PG8_MMA(0, 1, At, B1); PG8_BAR;
            PG8_LDA(At, 0, 1); PG8_STAGE(PG8_SA(0, 0), a2, voffA);
            PG8_BAR; PG8_WAIT_L(0); PG8_MMA(1, 0, At, B0); PG8_BAR; PG8_SCHED;
            PG8_STAGE(PG8_SB(0, 1), b2 + hstepB, voffB);
            PG8_WAIT_V(6); PG8_BAR; PG8_MMA(1, 1, At, B1); PG8_BAR;
            PG8_LDB(B0, 1, 0); PG8_SCHED; PG8_LDA(At, 1, 0); PG8_STAGE(PG8_SA(0, 1), a2 + hstepA, voffA);
            PG8_WAIT_L(8); PG8_BAR; PG8_WAIT_L(0); PG8_MMA(0, 0, At, B0); PG8_BAR; PG8_SCHED;
            PG8_LDB(B1, 1, 1); PG8_STAGE(PG8_SB(1, 0), b3, voffB);
            PG8_BAR; PG8_WAIT_L(0); PG8_MMA(0, 1, At, B1); PG8_BAR;
            PG8_LDA(At, 1, 1); PG8_STAGE(PG8_SA(1, 0), a3, voffA);
            PG8_BAR; PG8_WAIT_L(0); PG8_MMA(1, 0, At, B0); PG8_BAR; PG8_SCHED;
            PG8_STAGE(PG8_SB(1, 1), b3 + hstepB, voffB);
            PG8_WAIT_V(6); PG8_BAR; PG8_MMA(1, 1, At, B1); PG8_BAR;
            }
        }
        if constexpr (ALIGN_EPI) { if (wr == 0) PG8_BAR; }
        if constexpr (!Epi::AFTER_DRAIN) { E(acc, cur, wr, wc, fr, fq); S.done(cur); }
        if (!has_next) break;
#pragma unroll
        for (int a = 0; a < 2; ++a)
#pragma unroll
            for (int b = 0; b < 2; ++b)
#pragma unroll
                for (int m = 0; m < 4; ++m)
#pragma unroll
                    for (int n = 0; n < 2; ++n) acc[a][b][m][n] = (f32x4){0.f, 0.f, 0.f, 0.f};
        cur = nxt; cA = nA; cB = nB; ++ui;
        if constexpr (ALIGN_EPI) { if (wr == 1) PG8_BAR; }
    }
    PG8_WAIT_V(0);
    if constexpr (!ALIGN_EPI) { if (wr == 0) PG8_BAR; }
    PG8_BAR;
    if constexpr (Epi::AFTER_DRAIN) { E.fused(acc, cur, wr, wc, fr, fq, lds, wid, lane); S.done(cur); }
#undef PG8_SA
#undef PG8_SB
#undef PG8_STAGE
#undef PG8_LDA
#undef PG8_LDB
#undef PG8_MMA
#undef PG8_WAIT_V
#undef PG8_WAIT_L
#undef PG8_BAR
#undef PG8_SCHED
}
}
#ifndef PG8_SP2
#define PG8_SP2 true
#endif
#ifndef PG8_ALIGN
#define PG8_ALIGN true
#endif

typedef unsigned short bf16_t;
typedef short bf16x8 __attribute__((ext_vector_type(8)));
typedef float f32x4 __attribute__((ext_vector_type(4)));
typedef float f32x16 __attribute__((ext_vector_type(16)));
#define LAS __attribute__((address_space(3)))

constexpr int BATCH = 16, SEQ = 2048, DM = 1024, M = BATCH * SEQ, INC = 5128, NP = 5120, FF = 4096;
constexpr float EPS = 1e-6f, LOG2E = 1.4426950408889634f, C2 = 0.125f * LOG2E;
constexpr int C_DQ = 0, C_DK = 512, C_DV = 1024, C_FQ = 1536, C_FK = 2048, C_FV = 2560, C_G0 = 3072, C_G1 = 4096;
constexpr int C_OD = 0, C_MRG = 512, C_OF = 1536, C_T1 = 2048;

constexpr size_t MiB = 1u << 20;
constexpr size_t WS_WIN = 0, WS_WPA = 10 * MiB, WS_WPB = 11 * MiB, WS_WO = 12 * MiB, WS_W1 = 14 * MiB, WS_W2 = 22 * MiB;
constexpr size_t WS_LOGF = 30 * MiB, WS_FC = 31 * MiB, WS_BT = 32 * MiB, WS_CTL = 33 * MiB, WS_XN = 34 * MiB, WS_PROJ = 98 * MiB, WS_END = 418 * MiB;
constexpr int NWAVES = 8, NTHREADS = 512;
constexpr int LDS_BYTES = 147456;

struct Params {
    const float* x; const float* g_mix; const float* w_in; const float* b_f; const float* lq1; const float* lk1; const float* lq2; const float* lk2;
    const float* g_subln; const float* w_pa; const float* w_pb; const float* w_o; const float* g_mlp; const float* w_1; const float* w_2; const float* rel_table; const float* g_final;
    float* out; unsigned char* ws;
};

__device__ __forceinline__ unsigned f2bf(float f) { unsigned u = __builtin_bit_cast(unsigned, f); return (u + 0x7fffu + ((u >> 16) & 1u)) >> 16; }
__device__ __forceinline__ unsigned pk2(float lo, float hi) { return f2bf(lo) | (f2bf(hi) << 16); }
__device__ __forceinline__ float bf2f(bf16_t b) { return __builtin_bit_cast(float, (unsigned)b << 16); }
__device__ __forceinline__ float wave_sum(float v) {
#pragma unroll
    for (int o = 1; o < 64; o <<= 1) v += __shfl_xor(v, o);
    return v;
}
__device__ __forceinline__ int crow(int r, int hi) { return (r & 3) + 8 * (r >> 2) + 4 * hi; }

__device__ __forceinline__ void transpose_item(const float* W, int ldw, int K, bf16_t* WT, LAS float* scr, int kb, int nb, int lane) {
    const int k0 = 64 * kb, n0 = 32 * nb;
#pragma unroll 8
    for (int i = 0; i < 32; ++i) { const int kk = 2 * i + (lane >> 5); scr[kk * 33 + (lane & 31)] = W[(size_t)(k0 + kk) * ldw + n0 + (lane & 31)]; }
    asm volatile("s_waitcnt lgkmcnt(0)" ::: "memory");
    const int c = lane & 7;
#pragma unroll
    for (int j = 0; j < 4; ++j) { const int n = (lane >> 3) + 8 * j; const LAS float* s = scr + (8 * c) * 33 + n;
        uint4 o; o.x = pk2(s[0 * 33], s[1 * 33]); o.y = pk2(s[2 * 33], s[3 * 33]); o.z = pk2(s[4 * 33], s[5 * 33]); o.w = pk2(s[6 * 33], s[7 * 33]);
        *(uint4*)(WT + (size_t)(n0 + n) * K + k0 + 8 * c) = o; }
    asm volatile("s_waitcnt lgkmcnt(0)" ::: "memory");
}

__device__ __forceinline__ int rel_bucket(int rel) {
    const int ret = rel > 0 ? 16 : 0; const int n = rel < 0 ? -rel : rel;
    int v;
    if (n < 8) v = n; else { int lg = (31 - __clz(n * n)) - 6; v = 8 + lg; if (v > 15) v = 15; }
    return ret + v;
}

__device__ __forceinline__ void norm_row(const float* xrow, const float* g, bf16_t* orow, const float* wfl  , const float* b_f, float* logf_row, int lane) {
    f32x4 v[4]; float s = 0.f;
#pragma unroll
    for (int j = 0; j < 4; ++j) { v[j] = *(const f32x4*)(xrow + 4 * lane + 256 * j); s += (v[j].x * v[j].x + v[j].y * v[j].y) + (v[j].z * v[j].z + v[j].w * v[j].w); }
    const float r = 1.0f / sqrtf(wave_sum(s) * (1.f / DM) + EPS);
    float fl[8];
#pragma unroll
    for (int h = 0; h < 8; ++h) fl[h] = 0.f;
#pragma unroll
    for (int j = 0; j < 4; ++j) {
        const f32x4 gg = *(const f32x4*)(g + 4 * lane + 256 * j);
        f32x4 y; y.x = v[j].x * r * gg.x; y.y = v[j].y * r * gg.y; y.z = v[j].z * r * gg.z; y.w = v[j].w * r * gg.w;
        uint2 o; o.x = pk2(y.x, y.y); o.y = pk2(y.z, y.w);
        *(uint2*)(orow + 4 * lane + 256 * j) = o;
        if (wfl) {
#pragma unroll
            for (int e = 0; e < 4; ++e) { const int k = 4 * lane + 256 * j + e; const float yy = y[e];
                const f32x4 w0 = *(const f32x4*)(wfl + (size_t)k * INC), w1 = *(const f32x4*)(wfl + (size_t)k * INC + 4);
                fl[0] += yy * w0.x; fl[1] += yy * w0.y; fl[2] += yy * w0.z; fl[3] += yy * w0.w; fl[4] += yy * w1.x; fl[5] += yy * w1.y; fl[6] += yy * w1.z; fl[7] += yy * w1.w; }
        }
    }
    if (wfl) {
#pragma unroll
        for (int h = 0; h < 8; ++h) fl[h] = wave_sum(fl[h]);
        if (lane < 8) { float z = 0.f;
#pragma unroll
            for (int h = 0; h < 8; ++h) if (lane == h) z = fl[h];
            z += b_f[lane];
            const float ls = fminf(z, 0.f) - log1pf(expf(-fabsf(z)));
            logf_row[lane] = ls; }
    }
}

__device__ __forceinline__ void phase_prologue(const Params& P, LAS unsigned char* lds, int bid, int nblk) {
    const int tid = threadIdx.x, lane = tid & 63, wave = tid >> 6, nw = NWAVES;
    const int gw = bid * nw + wave, NGW = nblk * nw;
    LAS float* scr = (LAS float*)lds + wave * (64 * 33);
    unsigned char* ws = P.ws;
    constexpr int I_INA = 16 * 96, I_INB = 16 * 64, I_PA = 8 * 32, I_PB = 8 * 32, I_O = 16 * 32, I_1 = 16 * 128, I_2 = 64 * 32;
    constexpr int NITEMS = I_INA + I_INB + I_PA + I_PB + I_O + I_1 + I_2;
    for (int it = gw; it < NITEMS; it += NGW) {
        int r = it;
        if (r < I_INA) { transpose_item(P.w_in, INC, 1024, (bf16_t*)(ws + WS_WIN), scr, r / 96, r % 96, lane); continue; } r -= I_INA;
        if (r < I_INB) { transpose_item(P.w_in + 3080, INC, 1024, (bf16_t*)(ws + WS_WIN) + (size_t)3072 * 1024, scr, r / 64, r % 64, lane); continue; } r -= I_INB;
        if (r < I_PA) { transpose_item(P.w_pa, 1024, 512, (bf16_t*)(ws + WS_WPA), scr, r / 32, r % 32, lane); continue; } r -= I_PA;
        if (r < I_PB) { transpose_item(P.w_pb, 1024, 512, (bf16_t*)(ws + WS_WPB), scr, r / 32, r % 32, lane); continue; } r -= I_PB;
        if (r < I_O) { transpose_item(P.w_o, 1024, 1024, (bf16_t*)(ws + WS_WO), scr, r / 32, r % 32, lane); continue; } r -= I_O;
        if (r < I_1) { transpose_item(P.w_1, 4096, 1024, (bf16_t*)(ws + WS_W1), scr, r / 128, r % 128, lane); continue; } r -= I_1;
        transpose_item(P.w_2, 1024, 4096, (bf16_t*)(ws + WS_W2), scr, r / 32, r % 32, lane);
    }
    if (bid == 0) {
        float* BT = (float*)(ws + WS_BT);
        for (int i = tid; i < 4 * 256; i += NTHREADS) { const int h = i >> 8, rel = (i & 255) - 192;
            BT[i] = (P.rel_table[rel_bucket(rel) * 4 + h] - P.rel_table[15 * 4 + h]) * LOG2E; }
    }
    for (int m = gw; m < M; m += NGW)
        norm_row(P.x + (size_t)m * DM, P.g_mix, (bf16_t*)(ws + WS_XN) + (size_t)m * DM, P.w_in + 3072, P.b_f, (float*)(ws + WS_LOGF) + (size_t)m * 8, lane);
}

__device__ __forceinline__ void phase_cumsum(const Params& P, int bid, int nblk) {
    const int tid = threadIdx.x, lane = tid & 63, wave = tid >> 6, nw = NWAVES;
    const int gw = bid * nw + wave, NGW = nblk * nw;
    const float* LF = (const float*)(P.ws + WS_LOGF); float* FC = (float*)(P.ws + WS_FC);
    for (int seq = gw; seq < BATCH * 8; seq += NGW) {
        const int b = seq >> 3, h = seq & 7;
        const size_t base = ((size_t)b * SEQ + lane * 32) * 8 + h;
        float loc[32]; float run = 0.f;
#pragma unroll
        for (int i = 0; i < 32; ++i) { run += LF[base + (size_t)i * 8]; loc[i] = run; }
        float incl = run;
#pragma unroll
        for (int o = 1; o < 64; o <<= 1) { const float t = __shfl_up(incl, o); if (lane >= o) incl += t; }
        const float excl = incl - run;
#pragma unroll
        for (int i = 0; i < 32; ++i) FC[base + (size_t)i * 8] = (loc[i] + excl) * LOG2E;
    }
}

template <int MODE>
__device__ __forceinline__ void attn_wave(const bf16_t* Qp, const bf16_t* Kp, const bf16_t* Vp, bf16_t* Op, int opitch, int q0, const float* fc  , const float* bt, int lane) {
    const int r32 = lane & 31, hi = lane >> 5;
    bf16x8 qr[4];
#pragma unroll
    for (int d0 = 0; d0 < 4; ++d0) qr[d0] = *(const bf16x8*)(Qp + (size_t)(q0 + r32) * NP + d0 * 16 + hi * 8);
    f32x16 o[2]; o[0] = f32x16{}; o[1] = f32x16{};
    float mrun = -INFINITY, lrun = 0.f;
    const int q = q0 + r32;
    const int kend = MODE == 0 ? q0 + 32 : ((q0 >> 6) + 1) * 64;
    for (int kv0 = 0; kv0 < kend; kv0 += 32) {
        f32x16 s = f32x16{};
#pragma unroll
        for (int d0 = 0; d0 < 4; ++d0) { const bf16x8 kf = *(const bf16x8*)(Kp + (size_t)(kv0 + r32) * NP + d0 * 16 + hi * 8);
            s = __builtin_amdgcn_mfma_f32_32x32x16_bf16(kf, qr[d0], s, 0, 0, 0); }
        float tmax = -INFINITY;
#pragma unroll
        for (int r = 0; r < 16; ++r) { const int kv = kv0 + crow(r, hi);
            if (MODE == 0) { s[r] = (kv > q) ? -INFINITY : s[r] - fc[(size_t)kv * 8]; }
            else { int rel = kv - q; if (rel < -192) rel = -192; s[r] += bt[rel + 192]; }
            tmax = fmaxf(tmax, s[r]); }
        tmax = fmaxf(tmax, __shfl_xor(tmax, 32));
        const float mnew = fmaxf(mrun, tmax);
        const float alpha = exp2f(mrun - mnew);
        mrun = mnew;
        float psum = 0.f;
#pragma unroll
        for (int r = 0; r < 16; ++r) { s[r] = exp2f(s[r] - mnew); psum += s[r]; }
        lrun = lrun * alpha + psum;
#pragma unroll
        for (int r = 0; r < 16; ++r) { const float a = __shfl(alpha, crow(r, hi)); o[0][r] *= a; o[1][r] *= a; }
#pragma unroll
        for (int st = 0; st < 2; ++st) {
            bf16x8 pa;
#pragma unroll
            for (int j = 0; j < 8; ++j) pa[j] = (short)f2bf(s[8 * st + j]);
#pragma unroll
            for (int d = 0; d < 2; ++d) {
                bf16x8 vb;
#pragma unroll
                for (int j = 0; j < 8; ++j) { const int kv = kv0 + 16 * st + 8 * (j >> 2) + 4 * hi + (j & 3); vb[j] = (short)Vp[(size_t)kv * NP + d * 32 + r32]; }
                o[d] = __builtin_amdgcn_mfma_f32_32x32x16_bf16(pa, vb, o[d], 0, 0, 0);
            }
        }
    }
    const float ltot = lrun + __shfl_xor(lrun, 32);
    const float linv = 1.0f / ltot;
#pragma unroll
    for (int r = 0; r < 16; ++r) { const int qr_ = crow(r, hi); const float li = __shfl(linv, qr_);
#pragma unroll
        for (int d = 0; d < 2; ++d) Op[(size_t)(q0 + qr_) * opitch + d * 32 + r32] = (bf16_t)f2bf(o[d][r] * li); }
}

__device__ __forceinline__ void phase_attention_simple(const Params& P, int bid, int nblk) {
    const int tid = threadIdx.x, lane = tid & 63, wave = tid >> 6, nw = NWAVES;
    const int gw = bid * nw + wave, NGW = nblk * nw;
    bf16_t* PROJ = (bf16_t*)(P.ws + WS_PROJ); bf16_t* ODRAW = (bf16_t*)(P.ws + WS_XN); bf16_t* OFB = (bf16_t*)(P.ws + WS_XN);
    const float* FC = (const float*)(P.ws + WS_FC); const float* BT = (const float*)(P.ws + WS_BT);
    const int NIT = 64 * BATCH * 24;
    for (int it = gw; it < NIT; it += NGW) {
        const int qb = 63 - it / (BATCH * 24), rem = it % (BATCH * 24), b = rem / 24, vh = rem % 24;
        const size_t rb = (size_t)b * SEQ; bf16_t* base = PROJ + rb * NP;
        if (vh < 8) {
            const int h = vh;
            attn_wave<0>(base + C_FQ + h * 64, base + C_FK + h * 64, base + C_FV + h * 64, base + C_OF + h * 64, NP, qb * 32, FC + rb * 8 + h, nullptr, lane);
        } else {
            const int v = vh - 8, h = v >> 2, mp = (v >> 1) & 1, vhf = v & 1;
            attn_wave<1>(base + C_DQ + h * 128 + mp * 64, base + C_DK + h * 128 + mp * 64, base + C_DV + h * 128 + vhf * 64, ODRAW + rb * 1024 + h * 256 + mp * 128 + vhf * 64, 1024, qb * 32, nullptr, BT + h * 256, lane);
        }
    }
}

__device__ __forceinline__ void phase_combine(const Params& P, int bid, int nblk) {
    const int tid = threadIdx.x, lane = tid & 63, wave = tid >> 6, nw = NWAVES;
    const int gw = bid * nw + wave, NGW = nblk * nw;
    const float s1 = wave_sum(P.lq1[lane] * P.lk1[lane]), s2 = wave_sum(P.lq2[lane] * P.lk2[lane]);
    const float lam = expf(s1) - expf(s2) + 0.2f;
    bf16_t* PROJ = (bf16_t*)(P.ws + WS_PROJ); const bf16_t* ODRAW = (const bf16_t*)(P.ws + WS_XN);
    const int h = lane >> 4, e0 = (lane & 15) * 8;
    float g[8];
#pragma unroll
    for (int j = 0; j < 8; ++j) g[j] = P.g_subln[e0 + j] * 0.8f;
    for (int m = gw; m < M; m += NGW) {
        const bf16x8 a = *(const bf16x8*)(ODRAW + (size_t)m * 1024 + h * 256 + e0), b = *(const bf16x8*)(ODRAW + (size_t)m * 1024 + h * 256 + 128 + e0);
        float v[8]; float ss = 0.f;
#pragma unroll
        for (int j = 0; j < 8; ++j) { v[j] = bf2f((bf16_t)a[j]) - lam * bf2f((bf16_t)b[j]); ss += v[j] * v[j]; }
        ss += __shfl_xor(ss, 1); ss += __shfl_xor(ss, 2); ss += __shfl_xor(ss, 4); ss += __shfl_xor(ss, 8);
        const float r = 1.0f / sqrtf(ss * (1.f / 128.f) + EPS);
        uint4 o; o.x = pk2(v[0] * r * g[0], v[1] * r * g[1]); o.y = pk2(v[2] * r * g[2], v[3] * r * g[3]); o.z = pk2(v[4] * r * g[4], v[5] * r * g[5]); o.w = pk2(v[6] * r * g[6], v[7] * r * g[7]);
        *(uint4*)(PROJ + (size_t)m * NP + C_OD + h * 128 + e0) = o;
    }
}

__device__ __forceinline__ void phase_norm2(const Params& P, int bid, int nblk) {
    const int tid = threadIdx.x, lane = tid & 63, wave = tid >> 6, nw = NWAVES;
    const int gw = bid * nw + wave, NGW = nblk * nw;
    for (int m = gw; m < M; m += NGW) norm_row(P.out + (size_t)m * DM, P.g_mlp, (bf16_t*)(P.ws + WS_XN) + (size_t)m * DM, nullptr, nullptr, nullptr, lane);
}
__device__ __forceinline__ void phase_final(const Params& P, int bid, int nblk) {
    const int tid = threadIdx.x, lane = tid & 63, wave = tid >> 6, nw = NWAVES;
    const int gw = bid * nw + wave, NGW = nblk * nw;
    for (int m = gw; m < M; m += NGW) {
        float* row = P.out + (size_t)m * DM; f32x4 v[4]; float s = 0.f;
#pragma unroll
        for (int j = 0; j < 4; ++j) { v[j] = *(const f32x4*)(row + 4 * lane + 256 * j); s += (v[j].x * v[j].x + v[j].y * v[j].y) + (v[j].z * v[j].z + v[j].w * v[j].w); }
        const float r = 1.0f / sqrtf(wave_sum(s) * (1.f / DM) + EPS);
#pragma unroll
        for (int j = 0; j < 4; ++j) { const f32x4 gg = *(const f32x4*)(P.g_final + 4 * lane + 256 * j); f32x4 y; y.x = v[j].x * r * gg.x; y.y = v[j].y * r * gg.y; y.z = v[j].z * r * gg.z; y.w = v[j].w * r * gg.w;
            *(f32x4*)(row + 4 * lane + 256 * j) = y; }
    }
}

__global__ void __launch_bounds__(NTHREADS, 2) fwd_mega(Params P) {
    extern __shared__ __attribute__((aligned(16))) unsigned char lds_raw[];
    LAS unsigned char* lds = (LAS unsigned char*)lds_raw;
    cg::grid_group grid = cg::this_grid();
    const int bid = blockIdx.x, G = gridDim.x;
    bf16_t* PROJ = (bf16_t*)(P.ws + WS_PROJ); bf16_t* XN = (bf16_t*)(P.ws + WS_XN);
#define GRID_BAR() grid.sync()
    phase_prologue(P, lds, bid, G);
    GRID_BAR();
    phase_cumsum(P, bid, G);
    { pg8::Gemm g{XN, (const bf16_t*)(P.ws + WS_WIN), M, NP, 1024, 1024, 1024}; pg8::StaticOrder S; S.init(M, NP, G, bid);
      pg8::EpiProj E{PROJ}; pg8::gemm_phase<pg8::EpiProj, pg8::StaticOrder, PG8_ALIGN, PG8_SP2>(lds, g, S, E); }
    GRID_BAR();
    phase_attention_simple(P, bid, G);
    GRID_BAR();
    phase_combine(P, bid, G);
    GRID_BAR();
    { pg8::Gemm g{PROJ + C_OD, (const bf16_t*)(P.ws + WS_WPA), M, 1024, 512, NP, 512}; pg8::StaticOrder S; S.init(M, 1024, G, bid);
      pg8::EpiGate E{PROJ, C_G0, -1, C_T1}; pg8::gemm_phase<pg8::EpiGate, pg8::StaticOrder, PG8_ALIGN, PG8_SP2>(lds, g, S, E); }
    GRID_BAR();
    { pg8::Gemm g{PROJ + C_OF, (const bf16_t*)(P.ws + WS_WPB), M, 1024, 512, NP, 512}; pg8::StaticOrder S; S.init(M, 1024, G, bid);
      pg8::EpiGate E{PROJ, C_G1, C_T1, C_MRG}; pg8::gemm_phase<pg8::EpiGate, pg8::StaticOrder, PG8_ALIGN, PG8_SP2>(lds, g, S, E); }
    GRID_BAR();
    { pg8::Gemm g{PROJ + C_MRG, (const bf16_t*)(P.ws + WS_WO), M, 1024, 1024, NP, 1024}; pg8::StaticOrder S; S.init(M, 1024, G, bid);
      pg8::EpiResF32 E{P.x, P.out}; pg8::gemm_phase<pg8::EpiResF32, pg8::StaticOrder, PG8_ALIGN, PG8_SP2>(lds, g, S, E); }
    GRID_BAR();
    phase_norm2(P, bid, G);
    GRID_BAR();
    { pg8::Gemm g{XN, (const bf16_t*)(P.ws + WS_W1), M, FF, 1024, 1024, 1024}; pg8::StaticOrder S; S.init(M, FF, G, bid);
      pg8::EpiRelu2 E{PROJ, FF}; pg8::gemm_phase<pg8::EpiRelu2, pg8::StaticOrder, PG8_ALIGN, PG8_SP2>(lds, g, S, E); }
    GRID_BAR();
    { pg8::Gemm g{PROJ, (const bf16_t*)(P.ws + WS_W2), M, 1024, FF, FF, FF}; pg8::StaticOrder S; S.init(M, 1024, G, bid);
      pg8::EpiResF32 E{P.out, P.out}; pg8::gemm_phase<pg8::EpiResF32, pg8::StaticOrder, PG8_ALIGN, PG8_SP2>(lds, g, S, E); }
    GRID_BAR();
    phase_final(P, bid, G);
}

extern "C" void kernel_launch(void* const* d_in, const int* in_sizes, int n_in, void* d_out, int out_size, void* d_ws, size_t ws_size, hipStream_t stream) {
    if (n_in != 17 || out_size != M * DM || ws_size < WS_END) { fprintf(stderr, "kernel_launch: unexpected shapes n_in %d out %d ws %zu\n", n_in, out_size, ws_size); return; }
    Params P{};
    P.x = (const float*)d_in[0]; P.g_mix = (const float*)d_in[1]; P.w_in = (const float*)d_in[2]; P.b_f = (const float*)d_in[3];
    P.lq1 = (const float*)d_in[4]; P.lk1 = (const float*)d_in[5]; P.lq2 = (const float*)d_in[6]; P.lk2 = (const float*)d_in[7];
    P.g_subln = (const float*)d_in[8]; P.w_pa = (const float*)d_in[9]; P.w_pb = (const float*)d_in[10]; P.w_o = (const float*)d_in[11];
    P.g_mlp = (const float*)d_in[12]; P.w_1 = (const float*)d_in[13]; P.w_2 = (const float*)d_in[14]; P.rel_table = (const float*)d_in[15]; P.g_final = (const float*)d_in[16];
    P.out = (float*)d_out; P.ws = (unsigned char*)d_ws;
    static int grid_blocks = 0;
    if (!grid_blocks) { int dev = 0, cus = 0, per_cu = 0; hipGetDevice(&dev); hipDeviceGetAttribute(&cus, hipDeviceAttributeMultiprocessorCount, dev);
        if (hipFuncSetAttribute((const void*)fwd_mega, hipFuncAttributeMaxDynamicSharedMemorySize, LDS_BYTES) != hipSuccess) fprintf(stderr, "kernel_launch: hipFuncSetAttribute failed\n");
        hipOccupancyMaxActiveBlocksPerMultiprocessor(&per_cu, fwd_mega, NTHREADS, LDS_BYTES);
        if (per_cu < 1) { fprintf(stderr, "kernel_launch: occupancy query says %d blocks per CU\n", per_cu); per_cu = 1; }
        (void)hipGetLastError();
        grid_blocks = cus;
    }
    void* args[] = {&P};
    hipError_t e = hipLaunchCooperativeKernel((void*)fwd_mega, dim3(grid_blocks), dim3(NTHREADS), args, LDS_BYTES, stream);
    if (e != hipSuccess) fprintf(stderr, "cooperative launch failed: %s (grid %d)\n", hipGetErrorString(e), grid_blocks);
}
```

```cpp
#include <hip/hip_runtime.h>
#include <hip/hip_cooperative_groups.h>
#include <hip/hip_bf16.h>
#include <cstdio>
#include <cstdint>
namespace cg = cooperative_groups;
namespace pg8 {
#define PG8_LAS __attribute__((address_space(3)))
typedef unsigned short bf16_t;
typedef short bf16x8 __attribute__((ext_vector_type(8)));
typedef float f32x4 __attribute__((ext_vector_type(4)));
typedef unsigned u32x4 __attribute__((ext_vector_type(4)));
constexpr int BM = 256, BK = 64, HALF = 128, HTB = HALF * BK * 2  , STAGE_BYTES = 8 * HTB, NXCD = 8, WGM = 8;

__host__ __device__ __forceinline__ int lds_byte(int r, int c) { const int st = (r >> 4) * 2 + (c >> 5), rr = r & 15, cc = c & 31, ob = rr * 64 + cc * 2; return st * 1024 + (ob ^ (((ob >> 9) & 1) << 5)); }
__host__ __device__ __forceinline__ void stage_rc(int b, int& R, int& C) { const int st = b / 1024, sb = b % 1024, swz = sb ^ (((sb >> 9) & 1) << 5); R = (st >> 1) * 16 + swz / 64; C = (st & 1) * 32 + (swz % 64) / 2; }
__host__ __device__ __forceinline__ int perm32(int rho) { const int n = rho >> 4, i = rho & 15; return 8 * (i >> 2) + 4 * n + (i & 3); }

struct Unit { int pm, pn; };
struct Gemm { const bf16_t* A; const bf16_t* Bt; int M, N, K, lda, ldb; };

struct StaticOrder {
    int nM, nN, nwg, G, c;
    __host__ __device__ void init(int M, int N, int G_, int c_) { nM = M / BM; nN = N / BM; nwg = nM * nN; G = G_; c = c_; }
    __host__ __device__ bool next(int i, Unit& u) const {
        const long L = (long)i * G + c; if (L >= nwg) return false;
        int wgid = (int)L; { const int q = nwg / NXCD, r = nwg % NXCD, xcd = wgid % NXCD, off = wgid / NXCD; wgid = (xcd < r ? xcd * (q + 1) : r * (q + 1) + (xcd - r) * q) + off; }
        const int nig = WGM * nN, gid = wgid / nig, fm = gid * WGM, gsz = (nM - fm) < WGM ? (nM - fm) : WGM;
        u.pm = fm + ((wgid % nig) % gsz); u.pn = (wgid % nig) / gsz; return true;
    }
    __device__ __forceinline__ void a_ready(const Unit&) const {}
    __device__ __forceinline__ void done(const Unit&) const {}
};


__device__ __forceinline__ unsigned cvt_pk_bf16(float lo, float hi) { unsigned r; asm volatile("v_cvt_pk_bf16_f32 %0, %1, %2" : "=v"(r) : "v"(lo), "v"(hi)); return r; }
__device__ __forceinline__ float bflo(unsigned w) { return __builtin_bit_cast(float, w << 16); }
__device__ __forceinline__ float bfhi(unsigned w) { return __builtin_bit_cast(float, w & 0xffff0000u); }
constexpr int PROJ_LD = 5120;
constexpr float EPI_C2 = 0.125f * 1.4426950408889634f;
struct EpiProj {
    static constexpr bool PERM = true, AFTER_DRAIN = false;
    bf16_t* O;
    __device__ __forceinline__ void operator()(const f32x4 (&acc)[2][2][4][2], const Unit& u, int wr, int wc, int fr, int fq) const {
        const int row0 = u.pm * BM + wr * 64 + fr, col0 = u.pn * BM + wc * 32 + 8 * fq;
        const bool gate = u.pn >= 12; const float sc = (u.pn < 2 || (u.pn >= 6 && u.pn < 8)) ? EPI_C2 : 1.0f;
#pragma unroll
        for (int ai = 0; ai < 2; ++ai)
#pragma unroll
            for (int m = 0; m < 4; ++m) { bf16_t* rowp = O + (size_t)(row0 + ai * HALF + m * 16) * PROJ_LD + col0;
#pragma unroll
                for (int bj = 0; bj < 2; ++bj) { f32x4 v0 = acc[ai][bj][m][0], v1 = acc[ai][bj][m][1];
                    if (gate) {
#pragma unroll
                        for (int e = 0; e < 4; ++e) { v0[e] = __builtin_amdgcn_rcpf(1.0f + __expf(-v0[e])); v1[e] = __builtin_amdgcn_rcpf(1.0f + __expf(-v1[e])); }
                    } else { v0 = v0 * sc; v1 = v1 * sc; }
                    u32x4 w; w.x = cvt_pk_bf16(v0[0], v0[1]); w.y = cvt_pk_bf16(v0[2], v0[3]); w.z = cvt_pk_bf16(v1[0], v1[1]); w.w = cvt_pk_bf16(v1[2], v1[3]);
                    *(u32x4*)(rowp + bj * HALF) = w; } }
    }
};
struct EpiGate {
    static constexpr bool PERM = true, AFTER_DRAIN = false;
    bf16_t* P; int c_gate, c_add, c_out;
    __device__ __forceinline__ void operator()(const f32x4 (&acc)[2][2][4][2], const Unit& u, int wr, int wc, int fr, int fq) const {
        const int row0 = u.pm * BM + wr * 64 + fr, col0 = u.pn * BM + wc * 32 + 8 * fq;
#pragma unroll
        for (int ai = 0; ai < 2; ++ai)
#pragma unroll
            for (int m = 0; m < 4; ++m) { bf16_t* rowp = P + (size_t)(row0 + ai * HALF + m * 16) * PROJ_LD + col0;
#pragma unroll
                for (int bj = 0; bj < 2; ++bj) { const f32x4 v0 = acc[ai][bj][m][0], v1 = acc[ai][bj][m][1];
                    const u32x4 g = *(const u32x4*)(rowp + c_gate + bj * HALF);
                    float o[8] = {v0[0] * bflo(g.x), v0[1] * bfhi(g.x), v0[2] * bflo(g.y), v0[3] * bfhi(g.y), v1[0] * bflo(g.z), v1[1] * bfhi(g.z), v1[2] * bflo(g.w), v1[3] * bfhi(g.w)};
                    if (c_add >= 0) { const u32x4 a = *(const u32x4*)(rowp + c_add + bj * HALF);
                        o[0] += bflo(a.x); o[1] += bfhi(a.x); o[2] += bflo(a.y); o[3] += bfhi(a.y); o[4] += bflo(a.z); o[5] += bfhi(a.z); o[6] += bflo(a.w); o[7] += bfhi(a.w); }
                    u32x4 w; w.x = cvt_pk_bf16(o[0], o[1]); w.y = cvt_pk_bf16(o[2], o[3]); w.z = cvt_pk_bf16(o[4], o[5]); w.w = cvt_pk_bf16(o[6], o[7]);
                    *(u32x4*)(rowp + c_out + bj * HALF) = w; } }
    }
};
struct EpiResF32 {
    static constexpr bool PERM = false, AFTER_DRAIN = false;
    const float* base; float* out;
    __device__ __forceinline__ void operator()(const f32x4 (&acc)[2][2][4][2], const Unit& u, int wr, int wc, int fr, int fq) const {
        const int row0 = u.pm * BM + wr * 64 + fr, col0 = u.pn * BM + wc * 32 + 4 * fq;
#pragma unroll
        for (int ai = 0; ai < 2; ++ai)
#pragma unroll
            for (int m = 0; m < 4; ++m) { const size_t off = (size_t)(row0 + ai * HALF + m * 16) * 1024 + col0;
#pragma unroll
                for (int bj = 0; bj < 2; ++bj)
#pragma unroll
                    for (int n = 0; n < 2; ++n) { const f32x4 b = *(const f32x4*)(base + off + bj * HALF + n * 16); *(f32x4*)(out + off + bj * HALF + n * 16) = b + acc[ai][bj][m][n]; } }
    }
};
struct EpiRelu2 {
    static constexpr bool PERM = true, AFTER_DRAIN = false;
    bf16_t* O; int ldc;
    __device__ __forceinline__ void operator()(const f32x4 (&acc)[2][2][4][2], const Unit& u, int wr, int wc, int fr, int fq) const {
        const int row0 = u.pm * BM + wr * 64 + fr, col0 = u.pn * BM + wc * 32 + 8 * fq;
#pragma unroll
        for (int ai = 0; ai < 2; ++ai)
#pragma unroll
            for (int m = 0; m < 4; ++m) { bf16_t* rowp = O + (size_t)(row0 + ai * HALF + m * 16) * ldc + col0;
#pragma unroll
                for (int bj = 0; bj < 2; ++bj) { f32x4 v0 = acc[ai][bj][m][0], v1 = acc[ai][bj][m][1];
#pragma unroll
                    for (int e = 0; e < 4; ++e) { const float a = fmaxf(v0[e], 0.f), b = fmaxf(v1[e], 0.f); v0[e] = a * a; v1[e] = b * b; }
                    u32x4 w; w.x = cvt_pk_bf16(v0[0], v0[1]); w.y = cvt_pk_bf16(v0[2], v0[3]); w.z = cvt_pk_bf16(v1[0], v1[1]); w.w = cvt_pk_bf16(v1[2], v1[3]);
                    *(u32x4*)(rowp + bj * HALF) = w; } }
    }
};

template <class Epi, class Sched, bool ALIGN_EPI = false, bool SP2 = false>
__device__ __forceinline__ void gemm_phase(PG8_LAS unsigned char* lds, const Gemm g, const Sched& S, const Epi& E) {
    int tid_ = threadIdx.x; asm volatile("" : "+v"(tid_));
    const int tid = tid_, wid = __builtin_amdgcn_readfirstlane(tid >> 6), lane = tid & 63, wr = wid >> 2, wc = wid & 3, fr = lane & 15, fq = lane >> 4;
    const int K = g.K, nt = K / BK;
    unsigned voffA[2], voffB[2];
#pragma unroll
    for (int i = 0; i < 2; ++i) { int R, C; stage_rc(tid * 16 + i * 8192, R, C); const int Rb = Epi::PERM ? ((R & ~31) + perm32(R & 31)) : R;
        voffA[i] = (unsigned)(R * g.lda + C) * 2u; voffB[i] = (unsigned)(Rb * g.ldb + C) * 2u; }
    const size_t kstep = (size_t)(BK * 2);
    const size_t hstepA = (size_t)HALF * g.lda * 2, hstepB = (size_t)HALF * g.ldb * 2;
    const size_t tstepA = 2 * hstepA, tstepB = 2 * hstepB;
    const unsigned ldsw = (unsigned)wid * 1024u;
    const int aoff = lds_byte(wr * 64 + fr, fq * 8), boff = lds_byte(wc * 32 + fr, fq * 8);
#define PG8_SA(b, h) (((b) * 2 + (h)) * HTB)
#define PG8_SB(b, h) ((4 + (b) * 2 + (h)) * HTB)
#define PG8_STAGE(bufoff, gbase, voff) do { _Pragma("unroll") for (int _i = 0; _i < 2; ++_i) \
        __builtin_amdgcn_global_load_lds((const unsigned*)((const char*)(gbase) + (voff)[_i]), (PG8_LAS unsigned*)(lds + (bufoff) + ldsw + _i * 8192), 16, 0, 0); } while (0)
#define PG8_LDA(dst, b, h) do { _Pragma("unroll") for (int m = 0; m < 4; ++m) _Pragma("unroll") for (int k = 0; k < 2; ++k) dst[m][k] = *(const PG8_LAS bf16x8*)(lds + PG8_SA(b, h) + aoff + m * 2048 + k * 1024); } while (0)
#define PG8_LDB(dst, b, h) do { _Pragma("unroll") for (int n = 0; n < 2; ++n) _Pragma("unroll") for (int k = 0; k < 2; ++k) dst[n][k] = *(const PG8_LAS bf16x8*)(lds + PG8_SB(b, h) + boff + n * 2048 + k * 1024); } while (0)
#define PG8_MMA(ai, bj, At, Bt) do { __builtin_amdgcn_s_setprio(1); _Pragma("unroll") for (int m = 0; m < 4; ++m) _Pragma("unroll") for (int n = 0; n < 2; ++n) _Pragma("unroll") for (int k = 0; k < 2; ++k) \
        acc[ai][bj][m][n] = __builtin_amdgcn_mfma_f32_16x16x32_bf16(Bt[n][k], At[m][k], acc[ai][bj][m][n], 0, 0, 0); __builtin_amdgcn_s_setprio(0); } while (0)
#define PG8_WAIT_V(n) asm volatile("s_waitcnt vmcnt(" #n ")" ::: "memory")
#define PG8_WAIT_L(n) asm volatile("s_waitcnt lgkmcnt(" #n ")" ::: "memory")
#define PG8_BAR __builtin_amdgcn_s_barrier()
#define PG8_SCHED __builtin_amdgcn_sched_barrier(0)
    Unit cur, nxt; int ui = 0;
    if (!S.next(0, cur)) return;
    f32x4 acc[2][2][4][2];
#pragma unroll
    for (int a = 0; a < 2; ++a)
#pragma unroll
        for (int b = 0; b < 2; ++b)
#pragma unroll
            for (int m = 0; m < 4; ++m)
#pragma unroll
                for (int n = 0; n < 2; ++n) acc[a][b][m][n] = (f32x4){0.f, 0.f, 0.f, 0.f};
    bf16x8 At[4][2], B0[2][2], B1[2][2];
    const char* cA = (const char*)g.A + (size_t)cur.pm * tstepA; const char* cB = (const char*)g.Bt + (size_t)cur.pn * tstepB;
    S.a_ready(cur);
    if constexpr (SP2) {
        PG8_STAGE(PG8_SB(0, 0), cB, voffB); PG8_STAGE(PG8_SB(0, 1), cB + hstepB, voffB); PG8_STAGE(PG8_SA(0, 0), cA, voffA); PG8_STAGE(PG8_SA(0, 1), cA + hstepA, voffA);
        if (wr == 1) PG8_BAR;
        PG8_WAIT_V(2); PG8_BAR;
        PG8_STAGE(PG8_SB(1, 0), cB + kstep, voffB); PG8_STAGE(PG8_SA(1, 0), cA + kstep, voffA); PG8_STAGE(PG8_SB(1, 1), cB + hstepB + kstep, voffB);
        PG8_WAIT_V(6); PG8_BAR;
    } else {
        PG8_STAGE(PG8_SB(0, 0), cB, voffB); PG8_STAGE(PG8_SA(0, 0), cA, voffA); PG8_STAGE(PG8_SB(0, 1), cB + hstepB, voffB); PG8_STAGE(PG8_SA(0, 1), cA + hstepA, voffA);
        if (wr == 1) PG8_BAR;
        PG8_WAIT_V(4); PG8_BAR;
        PG8_STAGE(PG8_SB(1, 0), cB + kstep, voffB); PG8_STAGE(PG8_SA(1, 0), cA + kstep, voffA); PG8_STAGE(PG8_SB(1, 1), cB + hstepB + kstep, voffB);
        PG8_WAIT_V(6); PG8_BAR;
    }
    for (;;) {
        const bool has_next = S.next(ui + 1, nxt);
        const char* nA = has_next ? (const char*)g.A + (size_t)nxt.pm * tstepA : cA; const char* nB = has_next ? (const char*)g.Bt + (size_t)nxt.pn * tstepB : cB;
        for (int t = 0; t < nt; t += 2) {
            const bool last = (t == nt - 2);
            const char* a1 = cA + (size_t)(t + 1) * kstep;
            const char* a2 = last ? nA : cA + (size_t)(t + 2) * kstep; const char* b2 = last ? nB : cB + (size_t)(t + 2) * kstep;
            const char* a3 = a2 + kstep; const char* b3 = b2 + kstep;
            if (last && has_next) S.a_ready(nxt);
            if constexpr (SP2) {
            PG8_LDB(B0, 0, 0); PG8_LDB(B1, 0, 1); PG8_SCHED; PG8_LDA(At, 0, 0); PG8_STAGE(PG8_SA(1, 1), a1 + hstepA, voffA);
            PG8_WAIT_V(8); PG8_WAIT_L(0); PG8_BAR; PG8_MMA(0, 0, At, B0); PG8_MMA(0, 1, At, B1); PG8_BAR; PG8_SCHED;
            PG8_LDA(At, 0, 1); PG8_STAGE(PG8_SB(0, 0), b2, voffB); PG8_STAGE(PG8_SB(0, 1), b2 + hstepB, voffB); PG8_STAGE(PG8_SA(0, 0), a2, voffA);
            PG8_WAIT_V(8); PG8_WAIT_L(0); PG8_BAR; PG8_MMA(1, 0, At, B0); PG8_MMA(1, 1, At, B1); PG8_BAR; PG8_SCHED;
            PG8_LDB(B0, 1, 0); PG8_LDB(B1, 1, 1); PG8_SCHED; PG8_LDA(At, 1, 0); PG8_STAGE(PG8_SA(0, 1), a2 + hstepA, voffA);
            PG8_WAIT_V(8); PG8_WAIT_L(0); PG8_BAR; PG8_MMA(0, 0, At, B0); PG8_MMA(0, 1, At, B1); PG8_BAR; PG8_SCHED;
            PG8_LDA(At, 1, 1); PG8_STAGE(PG8_SB(1, 0), b3, voffB); PG8_STAGE(PG8_SB(1, 1), b3 + hstepB, voffB); PG8_STAGE(PG8_SA(1, 0), a3, voffA);
            PG8_WAIT_V(8); PG8_WAIT_L(0); PG8_BAR; PG8_MMA(1, 0, At, B0); PG8_MMA(1, 1, At, B1); PG8_BAR; PG8_SCHED;
            } else {
            PG8_LDB(B0, 0, 0); PG8_SCHED; PG8_LDA(At, 0, 0); PG8_STAGE(PG8_SA(1, 1), a1 + hstepA, voffA);
            PG8_WAIT_L(8); PG8_BAR; PG8_WAIT_L(0); PG8_MMA(0, 0, At, B0); PG8_BAR; PG8_SCHED;
            PG8_LDB(B1, 0, 1); PG8_STAGE(PG8_SB(0, 0), b2, voffB);
            PG8_BAR; PG8_WAIT_L(0); PG8_MMA(0, 1, At, B1); PG8_BAR;
            PG8_LDA(At, 0, 1); PG8_STAGE(PG8_SA(0, 0), a2, voffA);
            PG8_BAR; PG8_WAIT_L(0); PG8_MMA(1, 0, At, B0); PG8_BAR; PG8_SCHED;
            PG8_STAGE(PG8_SB(0, 1), b2 + hstepB, voffB);
            PG8_WAIT_V(6); PG8_BAR; PG8_MMA(1, 1, At, B1); PG8_BAR;
            PG8_LDB(B0, 1, 0); PG8_SCHED; PG8_LDA(At, 1, 0); PG8_STAGE(PG8_SA(0, 1), a2 + hstepA, voffA);
            PG8_WAIT_L(8); PG8_BAR; PG8_WAIT_L(0); PG8_MMA(0, 0, At, B0); PG8_BAR; PG8_SCHED;
            PG8_LDB(B1, 1, 1); PG8_STAGE(PG8_SB(1, 0), b3, voffB);
            PG8_BAR; PG8_WAIT_L(0); PG8_MMA(0, 1, At, B1); PG8_BAR;
            PG8_LDA(At, 1, 1); PG8_STAGE(PG8_SA(1, 0), a3, voffA);
            PG8_BAR; PG8_WAIT_L(0); PG8_MMA(1, 0, At, B0); PG8_BAR; PG8_SCHED;
            PG8_STAGE(PG8_SB(1, 1), b3 + hstepB, voffB);
            PG8_WAIT_V(6); PG8_BAR; PG8_MMA(1, 1, At, B1); PG8_BAR;
            }
        }
        if constexpr (ALIGN_EPI) { if (wr == 0) PG8_BAR; }
        if constexpr (!Epi::AFTER_DRAIN) { E(acc, cur, wr, wc, fr, fq); S.done(cur); }
        if (!has_next) break;
#pragma unroll
        for (int a = 0; a < 2; ++a)
#pragma unroll
            for (int b = 0; b < 2; ++b)
#pragma unroll
                for (int m = 0; m < 4; ++m)
#pragma unroll
                    for (int n = 0; n < 2; ++n) acc[a][b][m][n] = (f32x4){0.f, 0.f, 0.f, 0.f};
        cur = nxt; cA = nA; cB = nB; ++ui;
        if constexpr (ALIGN_EPI) { if (wr == 1) PG8_BAR; }
    }
    PG8_WAIT_V(0);
    if constexpr (!ALIGN_EPI) { if (wr == 0) PG8_BAR; }
    PG8_BAR;
    if constexpr (Epi::AFTER_DRAIN) { E.fused(acc, cur, wr, wc, fr, fq, lds, wid, lane); S.done(cur); }
#undef PG8_SA
#undef PG8_SB
#undef PG8_STAGE
#undef PG8_LDA
#undef PG8_LDB
#undef PG8_MMA
#undef PG8_WAIT_V
#undef PG8_WAIT_L
#undef PG8_BAR
#undef PG8_SCHED
}
}
namespace attn_body {
using bf16=__hip_bfloat16;
using bf16x8=__attribute__((ext_vector_type(8)))short;
using s16x4=__attribute__((ext_vector_type(4)))short;
using f32x16=__attribute__((ext_vector_type(16)))float;
using u32x4=__attribute__((ext_vector_type(4)))unsigned;
using f32x4=__attribute__((ext_vector_type(4)))float;
constexpr int SEQ=2048,D=64,DM=5120;
constexpr int NW=8,QBLK=32,QB=QBLK*NW,KVBLK=64,NQB=SEQ/QB;
constexpr int ATTN_PITCH=DM, ATTN_UNIT_ROWS=QB;
__device__ __forceinline__ int crow(int r,int hi){return (r&3)+8*(r>>2)+4*hi;}
#define SBAR() __builtin_amdgcn_sched_barrier(0)
__device__ __forceinline__ void cmask(f32x16&p0,f32x16&p1,int jb,int qrel,int hi){
  const float NEG=-INFINITY; int kb=64*jb+4*hi;
  #pragma unroll
  for(int r=0;r<16;++r){int kv=kb+(r&3)+8*(r>>2); if(kv>qrel)p0[r]=NEG; if(kv+32>qrel)p1[r]=NEG;}
}

__device__ __forceinline__ void dmask(f32x16&p0,f32x16&p1,int jb,int wid){
  if(jb>(wid>>1)){
    #pragma unroll
    for(int r=0;r<16;++r){p0[r]=-INFINITY;p1[r]=-INFINITY;}
  }
}
template<int MODE> __device__ __forceinline__ f32x16 csel(const f32x16&c,const f32x16&n){ if constexpr(MODE==0) return c; else return n; }

constexpr int NSLOT=3, SLOTB=8192;
constexpr int LDS_K=0, LDS_V=NSLOT*SLOTB, LDS_WS=2*NSLOT*SLOTB, LDS_OST=LDS_WS+NW*64*4, LDS_TAB=LDS_OST+NW*4096, LDS_BYTES=LDS_TAB+8192;
constexpr float C2=0.125f*1.4426950408889634f;
__device__ __forceinline__ void glds16(const void*gsrc,unsigned lds_dst){unsigned keep;
  asm volatile("s_mov_b32 %0, m0\n\ts_mov_b32 m0, %2\n\ts_nop 0\n\tglobal_load_lds_dwordx4 %1, off\n\ts_mov_b32 m0, %0":"=&s"(keep):"v"(gsrc),"s"(lds_dst):"memory");}
__device__ __forceinline__ float max3f(float a,float b,float c){float r;asm("v_max3_f32 %0, %1, %2, %3":"=v"(r):"v"(a),"v"(b),"v"(c));return r;}
__device__ __forceinline__ float max2f(float a,float b){float r;asm("v_max_f32_e32 %0, %1, %2":"=v"(r):"v"(a),"v"(b));return r;}
__device__ __forceinline__ float fadd_s(float a,float b){float r;asm("v_add_f32_e32 %0, %1, %2":"=v"(r):"v"(a),"v"(b));return r;}
__device__ __forceinline__ float fsub_s(float a,float b){float r;asm("v_sub_f32_e32 %0, %1, %2":"=v"(r):"v"(a),"v"(b));return r;}
typedef float f32x2_t __attribute__((ext_vector_type(2))); typedef __bf16 bf16x2_t __attribute__((ext_vector_type(2)));
__device__ __forceinline__ unsigned cvtpk_s(float lo,float hi){f32x2_t v={lo,hi};bf16x2_t b=__builtin_convertvector(v,bf16x2_t);return __builtin_bit_cast(unsigned,b);}
#define WAIT_BAR(N) asm volatile("s_waitcnt vmcnt(" #N ") lgkmcnt(0)\n\ts_barrier":::"memory")

__device__ __forceinline__ void qkt(f32x16&p0,f32x16&p1,const char*Kslot,const bf16x8*qr,const f32x16&c0,const f32x16&c1,int r32,int hi){
  const char*kb=Kslot+hi*1024+r32*16;
  #pragma unroll
  for(int d0=0;d0<4;++d0){
    const bf16x8 b0=*reinterpret_cast<const bf16x8*>(kb+d0*2048);
    const bf16x8 b1=*reinterpret_cast<const bf16x8*>(kb+d0*2048+512);
    if(d0==0){p0=__builtin_amdgcn_mfma_f32_32x32x16_bf16(b0,qr[0],c0,0,0,0);p1=__builtin_amdgcn_mfma_f32_32x32x16_bf16(b1,qr[0],c1,0,0,0);}
    else{p0=__builtin_amdgcn_mfma_f32_32x32x16_bf16(b0,qr[d0],p0,0,0,0);p1=__builtin_amdgcn_mfma_f32_32x32x16_bf16(b1,qr[d0],p1,0,0,0);}}
}
typedef __attribute__((address_space(3))) const char* lds_cptr;
typedef short v4i16_t __attribute__((ext_vector_type(4)));
__device__ __forceinline__ void kload8(bf16x8*kf,lds_cptr kp){
  kf[0]=*(const __attribute__((address_space(3))) bf16x8*)(kp);      kf[1]=*(const __attribute__((address_space(3))) bf16x8*)(kp+512);
  kf[2]=*(const __attribute__((address_space(3))) bf16x8*)(kp+2048); kf[3]=*(const __attribute__((address_space(3))) bf16x8*)(kp+2560);
  kf[4]=*(const __attribute__((address_space(3))) bf16x8*)(kp+4096); kf[5]=*(const __attribute__((address_space(3))) bf16x8*)(kp+4608);
  kf[6]=*(const __attribute__((address_space(3))) bf16x8*)(kp+6144); kf[7]=*(const __attribute__((address_space(3))) bf16x8*)(kp+6656);
}
__device__ __forceinline__ void kload2(bf16x8*kf,lds_cptr kp,int j){ kf[2*j]=*(const __attribute__((address_space(3))) bf16x8*)(kp+j*2048); kf[2*j+1]=*(const __attribute__((address_space(3))) bf16x8*)(kp+j*2048+512); }
__device__ __forceinline__ s16x4 vtr(lds_cptr p){ return __builtin_bit_cast(s16x4,__builtin_amdgcn_ds_read_tr16_b64_v4i16((__attribute__((address_space(3))) v4i16_t*)p)); }
__device__ __forceinline__ float rowmax(const f32x16&p0,const f32x16&p1){
  float a=max3f(p0[0],p0[1],p1[0]),b=max3f(p0[2],p0[3],p1[1]);a=max3f(a,p1[2],p1[3]);
  #pragma unroll
  for(int r=4;r<16;r+=4){a=max3f(a,p0[r],p0[r+1]);b=max3f(b,p0[r+2],p0[r+3]);a=max3f(a,p1[r],p1[r+1]);b=max3f(b,p1[r+2],p1[r+3]);}
  const float m=max2f(a,b);
  auto rr=__builtin_amdgcn_permlane32_swap(__float_as_uint(m),__float_as_uint(m),false,false);
  return max2f(__uint_as_float(rr[0]),__uint_as_float(rr[1]));
}
__device__ __forceinline__ void pv(f32x16*o,int vb,bf16x8 pa0,bf16x8 pa1,bf16x8 pa2,bf16x8 pa3){
  #pragma unroll
  for(int d0=0;d0<2;++d0){s16x4 lo[4],hi[4];
    #pragma unroll
    for(int ks=0;ks<4;++ks){
      asm volatile("ds_read_b64_tr_b16 %0,%1 offset:%c2":"=&v"(lo[ks]):"v"(vb),"i"(d0*4096+ks*1024):"memory");
      asm volatile("ds_read_b64_tr_b16 %0,%1 offset:%c2":"=&v"(hi[ks]):"v"(vb),"i"(d0*4096+ks*1024+512):"memory");}
    asm volatile("s_waitcnt lgkmcnt(0)":::"memory");SBAR();
    #define PK(k) (bf16x8){lo[k][0],lo[k][1],lo[k][2],lo[k][3],hi[k][0],hi[k][1],hi[k][2],hi[k][3]}
    o[d0]=__builtin_amdgcn_mfma_f32_32x32x16_bf16(pa0,PK(0),o[d0],0,0,0);
    o[d0]=__builtin_amdgcn_mfma_f32_32x32x16_bf16(pa1,PK(1),o[d0],0,0,0);
    o[d0]=__builtin_amdgcn_mfma_f32_32x32x16_bf16(pa2,PK(2),o[d0],0,0,0);
    o[d0]=__builtin_amdgcn_mfma_f32_32x32x16_bf16(pa3,PK(3),o[d0],0,0,0);
    #undef PK
  }
}

#ifndef ATTN_STORE16
#define ATTN_STORE16(p,v) (*(u32x4*)(p)=(v))
#endif
template<int MODE,int THRL,int OP> __device__ __forceinline__ void attn_unit(int qb,const bf16*Qh,const bf16*__restrict__ Kh,const bf16*__restrict__ Vh,bf16*Oh,const float*__restrict__ tabsrc,char*shm){
  int tid_=threadIdx.x; asm volatile("":"+v"(tid_)); const int tid=tid_,lane=tid&63,r32=lane&31,hi=lane>>5; const int wid=__builtin_amdgcn_readfirstlane(tid>>6);
  const int q0=qb*QB;
  const bf16*Qw=Qh+(long)(q0+wid*QBLK)*DM;
  const unsigned lds0=(unsigned)(uintptr_t)shm;
  float*wsf=(float*)(shm+LDS_WS)+wid*64;
  const bf16*ksrc=Kh+(long)lane*DM+wid*8;
  const bf16*vsrc=Vh+(long)(16*(wid&3)+(lane>>2))*DM+(wid>>2)*32+(lane&3)*8;
  const unsigned kdst=lds0+LDS_K+wid*1024, vdst=lds0+LDS_V+wid*1024;
  #define DMA_K(t,slot) glds16(ksrc+(long)(t)*KVBLK*DM,(unsigned)__builtin_amdgcn_readfirstlane(kdst+(slot)))
  #define DMA_V(t,slot) glds16(vsrc+(long)(t)*KVBLK*DM,(unsigned)__builtin_amdgcn_readfirstlane(vdst+(slot)))
  const int vb0=(int)(lds0+LDS_V)+((lane>>4)&1)*32+(lane&3)*8+(4*hi+((lane&15)>>2))*64;
  const char*Kbase=shm+LDS_K; bf16x8 kf[8];
  const lds_cptr shm3=(lds_cptr)shm; const lds_cptr kp0=shm3+LDS_K+hi*1024+r32*16; const lds_cptr vp0=shm3+LDS_V+((lane>>4)&1)*32+(lane&3)*8+(4*hi+((lane&15)>>2))*64;
  const int qrel=wid*QBLK+r32;
  const int NT=(q0+QB)/KVBLK;
  float*tab=(float*)(shm+LDS_TAB);
  if(MODE==0){ if(tid<(q0+QB)/4){ const f32x4 v_=*(const f32x4*)(tabsrc+4*tid); ((f32x4*)tab)[tid]=-v_; } }
  else { if(tid<112){ f32x4 v_={0.f,0.f,0.f,0.f}; if(tid>=48)v_=*(const f32x4*)(tabsrc+4*(tid-48)); ((f32x4*)tab)[tid]=v_; } }
  #define CINIT(C0,C1,t) do{ if(MODE==0){ const float*tb_=tab+(t)*64+4*hi; \
      _Pragma("unroll") for(int g_=0;g_<4;++g_){ const f32x4 a_=*(const f32x4*)(tb_+8*g_), b_=*(const f32x4*)(tb_+32+8*g_); \
        _Pragma("unroll") for(int e_=0;e_<4;++e_){ C0[4*g_+e_]=a_[e_]; C1[4*g_+e_]=b_[e_]; } } \
      _Pragma("unroll") for(int r_=0;r_<16;++r_){ C0[r_]-=mhat; C1[r_]-=mhat; } } \
    else { const int jb_=(t)-(NT-4); \
      if(jb_>=-2){ const float*b_=tab+(64*jb_+4*hi-qrel+384); \
        _Pragma("unroll") for(int r_=0;r_<16;++r_){ C0[r_]=b_[(r_&3)+8*(r_>>2)]; C1[r_]=b_[(r_&3)+8*(r_>>2)+32]; } \
        _Pragma("unroll") for(int r_=0;r_<16;++r_){ C0[r_]-=mhat; C1[r_]-=mhat; } } \
      else { _Pragma("unroll") for(int r_=0;r_<16;++r_){ C0[r_]=-mhat; C1[r_]=-mhat; } } } }while(0)
  DMA_K(0,0);DMA_V(0,0);DMA_K(1,SLOTB);
  bf16x8 qr[4];
  #pragma unroll
  for(int d0=0;d0<4;++d0)qr[d0]=*reinterpret_cast<const bf16x8*>(&Qw[(long)r32*DM+d0*16+hi*8]);
  float mhat=0.f,l_reg=0.f;f32x16 o[2];o[0]=f32x16{};o[1]=f32x16{};
  #define CMASK(P0,P1,t) do{int jb_=(t)-(NT-4); if(MODE==0){ if(jb_>=0)cmask(P0,P1,jb_,qrel,hi); } else { if(jb_>=0)dmask(P0,P1,jb_,wid); } }while(0)
  bool resc=false;
  #define START(P0,P1) do{ const float rm=rowmax(P0,P1); resc=false; \
    { const float dl=rm; mhat=fadd_s(mhat,dl); \
      _Pragma("unroll") for(int r=0;r<16;++r){P0[r]=fsub_s(P0[r],dl);P1[r]=fsub_s(P1[r],dl);} \
       } \
    _Pragma("unroll") for(int r=0;r<16;++r)P0[r]=__builtin_amdgcn_exp2f(P0[r]); }while(0)
  #define RESC() do{ if(resc){ asm volatile("s_waitcnt lgkmcnt(0)":::"memory"); \
      _Pragma("unroll") for(int d_=0;d_<2;++d_) _Pragma("unroll") for(int r=0;r<16;++r)o[d_][r]*=wsf[crow(r,hi)]; } }while(0)
  f32x16 pA0,pA1,pB0,pB1;
  int sl_prev=0,sl_cur=0,sl_next=SLOTB;
  #define ROT() do{sl_prev=sl_cur;sl_cur=sl_next;sl_next=(sl_next==(NSLOT-1)*SLOTB)?0:sl_next+SLOTB;}while(0)
  DMA_K(2,2*SLOTB);
  WAIT_BAR(3);
  CINIT(pA0,pA1,0);
  qkt(pA0,pA1,Kbase,qr,pA0,pA1,r32,hi);asm volatile("s_nop 15\n\ts_nop 7":"+v"(pA0),"+v"(pA1));CMASK(pA0,pA1,0);
  START(pA0,pA1);
  _Pragma("unroll") for(int r=0;r<16;++r)pA1[r]=__builtin_amdgcn_exp2f(pA1[r]);
  WAIT_BAR(0);
  DMA_K(3,0);DMA_V(1,SLOTB);
  ROT();
  kload8(kf,kp0+sl_cur);
  WAIT_BAR(2);
  s16x4 vlo[8],vhi[8]; u32x4 pw0,pw1,pw2,pw3;
  #define PKW(P,B) cvtpk_s(P[B],P[B+1])
  #define PAF(k) __builtin_bit_cast(bf16x8,pw##k)
  #define VFR(i) (bf16x8){vlo[i][0],vlo[i][1],vlo[i][2],vlo[i][3],vhi[i][0],vhi[i][1],vhi[i][2],vhi[i][3]}
  #define PIN(x) asm volatile("":"+v"(x))
  #define MX3(a,b,c) __builtin_fmaxf(__builtin_fmaxf((a),(b)),(c))
  #define GAPA(MF,A0,A1,A2,A3,W0,W1,PW) do{ MF; sacc+=A0; sacc+=A1; sacc+=A2; sacc+=A3; PIN(sacc); W0; W1; PIN(PW); SBAR(); }while(0)
  #define EX(v) __builtin_amdgcn_exp2f(v)
  #define GAPB(MF,X,B) do{ MF; X[B]=EX(X[B]); X[B+1]=EX(X[B+1]); X[B+2]=EX(X[B+2]); X[B+3]=EX(X[B+3]); PIN(X); SBAR(); }while(0)
  #define VRD(i) do{ vlo[i]=vtr(vp_+(((i)>>2)*4096+((i)&3)*1024)); vhi[i]=vtr(vp_+(((i)>>2)*4096+((i)&3)*1024+512)); }while(0)
  #define KRD(G,j) do{ if(G){ kload2(kf,kp0+sl_next,j); SBAR(); } }while(0)
  #define STEP(C0,C1,P0,P1,t,GK,GV,GL) do{ CINIT(C0,C1,t); SBAR(); \
    const lds_cptr vp_=vp0+sl_prev; \
    VRD(0); SBAR(); float sacc=(P0[0]+P0[1]); \
    GAPA(C0=__builtin_amdgcn_mfma_f32_32x32x16_bf16(kf[0],qr[0],C0,0,0,0), P0[2],P0[3],P0[4],P0[5],     pw0[0]=PKW(P0,0), pw0[1]=PKW(P0,2), pw0); \
    VRD(4); SBAR(); GAPA(C1=__builtin_amdgcn_mfma_f32_32x32x16_bf16(kf[1],qr[0],C1,0,0,0), P0[6],P0[7],P0[8],P0[9],     pw0[2]=PKW(P0,4), pw0[3]=PKW(P0,6), pw0); \
    VRD(1); SBAR(); GAPA(C0=__builtin_amdgcn_mfma_f32_32x32x16_bf16(kf[2],qr[1],C0,0,0,0),   P0[10],P0[11],P0[12],P0[13], pw1[0]=PKW(P0,8), pw1[1]=PKW(P0,10), pw1); \
    VRD(5); SBAR(); GAPA(C1=__builtin_amdgcn_mfma_f32_32x32x16_bf16(kf[3],qr[1],C1,0,0,0),   P0[14],P0[15],P1[0],P1[1],   pw1[2]=PKW(P0,12),pw1[3]=PKW(P0,14), pw1); \
    VRD(2); SBAR(); GAPA(C0=__builtin_amdgcn_mfma_f32_32x32x16_bf16(kf[4],qr[2],C0,0,0,0),   P1[2],P1[3],P1[4],P1[5],     pw2[0]=PKW(P1,0), pw2[1]=PKW(P1,2), pw2); \
    VRD(6); SBAR(); GAPA(C1=__builtin_amdgcn_mfma_f32_32x32x16_bf16(kf[5],qr[2],C1,0,0,0),   P1[6],P1[7],P1[8],P1[9],     pw2[2]=PKW(P1,4), pw2[3]=PKW(P1,6), pw2); \
    VRD(3); SBAR(); GAPA(C0=__builtin_amdgcn_mfma_f32_32x32x16_bf16(kf[6],qr[3],C0,0,0,0),   P1[10],P1[11],P1[12],P1[13], pw3[0]=PKW(P1,8), pw3[1]=PKW(P1,10), pw3); \
    VRD(7); SBAR(); GAPA(C1=__builtin_amdgcn_mfma_f32_32x32x16_bf16(kf[7],qr[3],C1,0,0,0),   P1[14],P1[15],0.f,0.f,       pw3[2]=PKW(P1,12),pw3[3]=PKW(P1,14), pw3); \
    l_reg+=sacc; \
    if(GK){DMA_K((t)+3,sl_cur);} if(GV){DMA_V((t)+1,sl_next);} \
    CMASK(C0,C1,t); \
    { float a=MX3(C0[0],C0[1],C1[0]),b=MX3(C0[2],C0[3],C1[1]); a=MX3(a,C1[2],C1[3]); \
      _Pragma("unroll") for(int r=4;r<16;r+=4){a=MX3(a,C0[r],C0[r+1]);b=MX3(b,C0[r+2],C0[r+3]);a=MX3(a,C1[r],C1[r+1]);b=MX3(b,C1[r+2],C1[r+3]);} \
      float rm=__builtin_fmaxf(a,b); { auto rr=__builtin_amdgcn_permlane32_swap(__float_as_uint(rm),__float_as_uint(rm),false,false); rm=__builtin_fmaxf(__uint_as_float(rr[0]),__uint_as_float(rr[1])); } \
      resc=false; \
      if(__builtin_expect(__any(rm>(float)THRL),0)){ const float dl=__builtin_fmaxf(rm,0.f); mhat+=dl; \
        _Pragma("unroll") for(int r=0;r<16;++r){C0[r]-=dl;C1[r]-=dl;} \
         \
        const float f=__builtin_amdgcn_exp2f(-dl); l_reg*=f; if(hi==0)wsf[r32]=f; resc=true; } } \
    SBAR(); \
    GAPB(o[0]=__builtin_amdgcn_mfma_f32_32x32x16_bf16(PAF(0),VFR(0),o[0],0,0,0), C0,0); \
    GAPB(o[1]=__builtin_amdgcn_mfma_f32_32x32x16_bf16(PAF(0),VFR(4),o[1],0,0,0), C0,4); \
    KRD(GL,0); GAPB(o[0]=__builtin_amdgcn_mfma_f32_32x32x16_bf16(PAF(1),VFR(1),o[0],0,0,0), C0,8); \
    KRD(GL,1); GAPB(o[1]=__builtin_amdgcn_mfma_f32_32x32x16_bf16(PAF(1),VFR(5),o[1],0,0,0), C0,12); \
    KRD(GL,2); GAPB(o[0]=__builtin_amdgcn_mfma_f32_32x32x16_bf16(PAF(2),VFR(2),o[0],0,0,0), C1,0); \
    KRD(GL,3); GAPB(o[1]=__builtin_amdgcn_mfma_f32_32x32x16_bf16(PAF(2),VFR(6),o[1],0,0,0), C1,4); \
    GAPB(o[0]=__builtin_amdgcn_mfma_f32_32x32x16_bf16(PAF(3),VFR(3),o[0],0,0,0), C1,8); \
    GAPB(o[1]=__builtin_amdgcn_mfma_f32_32x32x16_bf16(PAF(3),VFR(7),o[1],0,0,0), C1,12); \
    }while(0)
  int t=1;
  #undef CMASK
  #define CMASK(P0,P1,t) do{}while(0)
  for(;t+7<NT;t+=2){
    STEP(pB0,pB1,pA0,pA1,t,true,true,true);     WAIT_BAR(2); RESC(); ROT();
    STEP(pA0,pA1,pB0,pB1,t+1,true,true,true);   WAIT_BAR(2); RESC(); ROT();
  }
  #undef CMASK
  #define CMASK(P0,P1,t) do{int jb_=(t)-(NT-4); if(MODE==0){ if(jb_>=0)cmask(P0,P1,jb_,qrel,hi); } else { if(jb_>=0)dmask(P0,P1,jb_,wid); } }while(0)
  #define ENDW(tt) do{ if((tt)+3<NT){WAIT_BAR(2);} else if((tt)+2<NT){WAIT_BAR(1);} else {WAIT_BAR(0);} }while(0)
  for(;t+1<NT;t+=2){
    STEP(pB0,pB1,pA0,pA1,t,(t+3<NT),(t+1<NT),(t+1<NT));       ENDW(t);   RESC(); ROT();
    STEP(pA0,pA1,pB0,pB1,t+1,(t+4<NT),(t+2<NT),(t+2<NT));     ENDW(t+1); RESC(); ROT();
  }
  STEP(pB0,pB1,pA0,pA1,NT-1,false,false,false); RESC();
  { float sacc=pB0[0]+pB0[1]; _Pragma("unroll") for(int r=2;r<16;++r)sacc+=pB0[r]; _Pragma("unroll") for(int r=0;r<16;++r)sacc+=pB1[r]; l_reg+=sacc;
    pw0=(u32x4){PKW(pB0,0),PKW(pB0,2),PKW(pB0,4),PKW(pB0,6)};pw1=(u32x4){PKW(pB0,8),PKW(pB0,10),PKW(pB0,12),PKW(pB0,14)};pw2=(u32x4){PKW(pB1,0),PKW(pB1,2),PKW(pB1,4),PKW(pB1,6)};pw3=(u32x4){PKW(pB1,8),PKW(pB1,10),PKW(pB1,12),PKW(pB1,14)};
    SBAR(); pv(o,vb0+sl_cur,PAF(0),PAF(1),PAF(2),PAF(3)); }
  #undef PKW
  #undef PAF
  #undef VFR
  #undef PIN
  #undef MX3
  #undef GAPA
  #undef GAPB
  #undef EX
  #undef VRD
  #undef KRD
  #undef STEP
  #undef ENDW
  {auto rr=__builtin_amdgcn_permlane32_swap(__float_as_uint(l_reg),__float_as_uint(l_reg),false,false);l_reg=__uint_as_float(rr[0])+__uint_as_float(rr[1]);}
  if(hi==0)wsf[32+r32]=l_reg;asm volatile("s_waitcnt lgkmcnt(0)":::"memory");
  float rli[16];
  #pragma unroll
  for(int r=0;r<16;++r)rli[r]=__builtin_amdgcn_rcpf(wsf[32+crow(r,hi)]);
  bf16*Ow=Oh+(long)(q0+wid*QBLK)*OP;
  { bf16*stg=(bf16*)(shm+LDS_OST)+wid*2048;
    #pragma unroll
    for(int r=0;r<16;++r){const int orow=crow(r,hi);
      #pragma unroll
      for(int d0=0;d0<2;++d0)stg[orow*64+d0*32+r32]=__float2bfloat16(o[d0][r]*rli[r]);}
    asm volatile("s_waitcnt lgkmcnt(0)":::"memory");
    #pragma unroll
    for(int i=0;i<4;++i){const int row=i*8+(lane>>3),ch=lane&7; const u32x4 v=*(const u32x4*)(stg+row*64+ch*8); ATTN_STORE16(Ow+(long)row*OP+ch*8,v);} }
  asm volatile("s_waitcnt lgkmcnt(0)\n\ts_barrier":::"memory");
  #undef DMA_K
  #undef DMA_V
  #undef CINIT
  #undef CMASK
  #undef START
  #undef RESC
  #undef ROT
}
constexpr int ATTN_LDS_BYTES=LDS_BYTES;
#undef SBAR
#undef WAIT_BAR
}
#ifndef PG8_SP2
#define PG8_SP2 true
#endif
#ifndef PG8_ALIGN
#define PG8_ALIGN true
#endif

typedef unsigned short bf16_t;
typedef short bf16x8 __attribute__((ext_vector_type(8)));
typedef float f32x4 __attribute__((ext_vector_type(4)));
typedef float f32x16 __attribute__((ext_vector_type(16)));
#define LAS __attribute__((address_space(3)))

constexpr int BATCH = 16, SEQ = 2048, DM = 1024, M = BATCH * SEQ, INC = 5128, NP = 5120, FF = 4096;
constexpr float EPS = 1e-6f, LOG2E = 1.4426950408889634f, C2 = 0.125f * LOG2E;
constexpr int C_DQ = 0, C_DK = 512, C_DV = 1024, C_FQ = 1536, C_FK = 2048, C_FV = 2560, C_G0 = 3072, C_G1 = 4096;
constexpr int C_OD = 0, C_MRG = 512, C_OF = 1536, C_T1 = 2048;

constexpr size_t MiB = 1u << 20;
constexpr size_t WS_WIN = 0, WS_WPA = 10 * MiB, WS_WPB = 11 * MiB, WS_WO = 12 * MiB, WS_W1 = 14 * MiB, WS_W2 = 22 * MiB;
constexpr size_t WS_LOGF = 30 * MiB, WS_FC = 31 * MiB, WS_BT = 32 * MiB, WS_CTL = 33 * MiB, WS_XN = 34 * MiB, WS_PROJ = 98 * MiB, WS_END = 418 * MiB;
constexpr int NWAVES = 8, NTHREADS = 512;
constexpr int LDS_BYTES = 147456;

struct Params {
    const float* x; const float* g_mix; const float* w_in; const float* b_f; const float* lq1; const float* lk1; const float* lq2; const float* lk2;
    const float* g_subln; const float* w_pa; const float* w_pb; const float* w_o; const float* g_mlp; const float* w_1; const float* w_2; const float* rel_table; const float* g_final;
    float* out; unsigned char* ws;
};

__device__ __forceinline__ unsigned f2bf(float f) { unsigned u = __builtin_bit_cast(unsigned, f); return (u + 0x7fffu + ((u >> 16) & 1u)) >> 16; }
__device__ __forceinline__ unsigned pk2(float lo, float hi) { return f2bf(lo) | (f2bf(hi) << 16); }
__device__ __forceinline__ float bf2f(bf16_t b) { return __builtin_bit_cast(float, (unsigned)b << 16); }
__device__ __forceinline__ float wave_sum(float v) {
#pragma unroll
    for (int o = 1; o < 64; o <<= 1) v += __shfl_xor(v, o);
    return v;
}
__device__ __forceinline__ int crow(int r, int hi) { return (r & 3) + 8 * (r >> 2) + 4 * hi; }

__device__ __forceinline__ void transpose_item(const float* W, int ldw, int K, bf16_t* WT, LAS float* scr, int kb, int nb, int lane) {
    const int k0 = 64 * kb, n0 = 32 * nb;
#pragma unroll 8
    for (int i = 0; i < 32; ++i) { const int kk = 2 * i + (lane >> 5); scr[kk * 33 + (lane & 31)] = W[(size_t)(k0 + kk) * ldw + n0 + (lane & 31)]; }
    asm volatile("s_waitcnt lgkmcnt(0)" ::: "memory");
    const int c = lane & 7;
#pragma unroll
    for (int j = 0; j < 4; ++j) { const int n = (lane >> 3) + 8 * j; const LAS float* s = scr + (8 * c) * 33 + n;
        uint4 o; o.x = pk2(s[0 * 33], s[1 * 33]); o.y = pk2(s[2 * 33], s[3 * 33]); o.z = pk2(s[4 * 33], s[5 * 33]); o.w = pk2(s[6 * 33], s[7 * 33]);
        *(uint4*)(WT + (size_t)(n0 + n) * K + k0 + 8 * c) = o; }
    asm volatile("s_waitcnt lgkmcnt(0)" ::: "memory");
}

__device__ __forceinline__ int rel_bucket(int rel) {
    const int ret = rel > 0 ? 16 : 0; const int n = rel < 0 ? -rel : rel;
    int v;
    if (n < 8) v = n; else { int lg = (31 - __clz(n * n)) - 6; v = 8 + lg; if (v > 15) v = 15; }
    return ret + v;
}

__device__ __forceinline__ void norm_row(const float* xrow, const float* g, bf16_t* orow, const float* wfl  , const float* b_f, float* logf_row, int lane) {
    f32x4 v[4]; float s = 0.f;
#pragma unroll
    for (int j = 0; j < 4; ++j) { v[j] = *(const f32x4*)(xrow + 4 * lane + 256 * j); s += (v[j].x * v[j].x + v[j].y * v[j].y) + (v[j].z * v[j].z + v[j].w * v[j].w); }
    const float r = 1.0f / sqrtf(wave_sum(s) * (1.f / DM) + EPS);
    float fl[8];
#pragma unroll
    for (int h = 0; h < 8; ++h) fl[h] = 0.f;
#pragma unroll
    for (int j = 0; j < 4; ++j) {
        const f32x4 gg = *(const f32x4*)(g + 4 * lane + 256 * j);
        f32x4 y; y.x = v[j].x * r * gg.x; y.y = v[j].y * r * gg.y; y.z = v[j].z * r * gg.z; y.w = v[j].w * r * gg.w;
        uint2 o; o.x = pk2(y.x, y.y); o.y = pk2(y.z, y.w);
        *(uint2*)(orow + 4 * lane + 256 * j) = o;
        if (wfl) {
#pragma unroll
            for (int e = 0; e < 4; ++e) { const int k = 4 * lane + 256 * j + e; const float yy = y[e];
                const f32x4 w0 = *(const f32x4*)(wfl + (size_t)k * INC), w1 = *(const f32x4*)(wfl + (size_t)k * INC + 4);
                fl[0] += yy * w0.x; fl[1] += yy * w0.y; fl[2] += yy * w0.z; fl[3] += yy * w0.w; fl[4] += yy * w1.x; fl[5] += yy * w1.y; fl[6] += yy * w1.z; fl[7] += yy * w1.w; }
        }
    }
    if (wfl) {
#pragma unroll
        for (int h = 0; h < 8; ++h) fl[h] = wave_sum(fl[h]);
        if (lane < 8) { float z = 0.f;
#pragma unroll
            for (int h = 0; h < 8; ++h) if (lane == h) z = fl[h];
            z += b_f[lane];
            const float ls = fminf(z, 0.f) - log1pf(expf(-fabsf(z)));
            logf_row[lane] = ls; }
    }
}

__device__ __forceinline__ void phase_prologue(const Params& P, LAS unsigned char* lds, int bid, int nblk) {
    int tid_ = threadIdx.x; asm volatile("" : "+v"(tid_)); const int tid = tid_, lane = tid & 63, wave = tid >> 6, nw = NWAVES;
    const int gw = bid * nw + wave, NGW = nblk * nw;
    LAS float* scr = (LAS float*)lds + wave * (64 * 33);
    unsigned char* ws = P.ws;
    constexpr int I_INA = 16 * 96, I_INB = 16 * 64, I_PA = 8 * 32, I_PB = 8 * 32, I_O = 16 * 32, I_1 = 16 * 128, I_2 = 64 * 32;
    constexpr int NITEMS = I_INA + I_INB + I_PA + I_PB + I_O + I_1 + I_2;
    for (int it = gw; it < NITEMS; it += NGW) {
        int r = it;
        if (r < I_INA) { transpose_item(P.w_in, INC, 1024, (bf16_t*)(ws + WS_WIN), scr, r / 96, r % 96, lane); continue; } r -= I_INA;
        if (r < I_INB) { transpose_item(P.w_in + 3080, INC, 1024, (bf16_t*)(ws + WS_WIN) + (size_t)3072 * 1024, scr, r / 64, r % 64, lane); continue; } r -= I_INB;
        if (r < I_PA) { transpose_item(P.w_pa, 1024, 512, (bf16_t*)(ws + WS_WPA), scr, r / 32, r % 32, lane); continue; } r -= I_PA;
        if (r < I_PB) { transpose_item(P.w_pb, 1024, 512, (bf16_t*)(ws + WS_WPB), scr, r / 32, r % 32, lane); continue; } r -= I_PB;
        if (r < I_O) { transpose_item(P.w_o, 1024, 1024, (bf16_t*)(ws + WS_WO), scr, r / 32, r % 32, lane); continue; } r -= I_O;
        if (r < I_1) { transpose_item(P.w_1, 4096, 1024, (bf16_t*)(ws + WS_W1), scr, r / 128, r % 128, lane); continue; } r -= I_1;
        transpose_item(P.w_2, 1024, 4096, (bf16_t*)(ws + WS_W2), scr, r / 32, r % 32, lane);
    }
    if (bid == 0) {
        float* BT = (float*)(ws + WS_BT);
        for (int i = tid; i < 4 * 256; i += NTHREADS) { const int h = i >> 8, rel = (i & 255) - 192;
            BT[i] = (P.rel_table[rel_bucket(rel) * 4 + h] - P.rel_table[15 * 4 + h]) * LOG2E; }
    }
    for (int m = gw; m < M; m += NGW)
        norm_row(P.x + (size_t)m * DM, P.g_mix, (bf16_t*)(ws + WS_XN) + (size_t)m * DM, P.w_in + 3072, P.b_f, (float*)(ws + WS_LOGF) + (size_t)m * 8, lane);
}

__device__ __forceinline__ void phase_cumsum(const Params& P, int bid, int nblk) {
    int tid_ = threadIdx.x; asm volatile("" : "+v"(tid_)); const int tid = tid_, lane = tid & 63, wave = tid >> 6, nw = NWAVES;
    const int gw = bid * nw + wave, NGW = nblk * nw;
    const float* LF = (const float*)(P.ws + WS_LOGF); float* FC = (float*)(P.ws + WS_FC);
    for (int seq = gw; seq < BATCH * 8; seq += NGW) {
        const int b = seq >> 3, h = seq & 7;
        const size_t base = ((size_t)b * SEQ + lane * 32) * 8 + h;
        float loc[32]; float run = 0.f;
#pragma unroll
        for (int i = 0; i < 32; ++i) { run += LF[base + (size_t)i * 8]; loc[i] = run; }
        float incl = run;
#pragma unroll
        for (int o = 1; o < 64; o <<= 1) { const float t = __shfl_up(incl, o); if (lane >= o) incl += t; }
        const float excl = incl - run;
#pragma unroll
        for (int i = 0; i < 32; ++i) FC[(size_t)seq * SEQ + lane * 32 + i] = (loc[i] + excl) * LOG2E;
    }
}

__device__ __forceinline__ void phase_attention(const Params& P, char* lds, int bid, int G) {
    const int vcu = (G % 8 == 0) ? (bid % 8) * (G / 8) + bid / 8 : bid;
    const attn_body::bf16* PROJ = (const attn_body::bf16*)(P.ws + WS_PROJ); attn_body::bf16* ODRAW = (attn_body::bf16*)(P.ws + WS_XN);
    const float* FC = (const float*)(P.ws + WS_FC); const float* BT = (const float*)(P.ws + WS_BT);
    for (int c = vcu; c < 256; c += G) {
        const int b = c >> 4, k = c & 15; const size_t rb = (size_t)b * SEQ; const attn_body::bf16* base = PROJ + rb * NP;
        { const int h = k >> 1;
          for (int i = 0; i < 4; ++i) { const int s = 2 * (k & 1) + (i >> 1), qb = (i & 1) ? s : 7 - s;
              attn_body::attn_unit<0, 64, NP>(qb, base + C_FQ + h * 64, base + C_FK + h * 64, base + C_FV + h * 64, (attn_body::bf16*)base + C_OF + h * 64, FC + (size_t)(b * 8 + h) * SEQ, lds); } }
        { const int hd = k >> 2, mp = (k >> 1) & 1, vhf = k & 1;
          for (int qb = 7; qb >= 0; --qb)
              attn_body::attn_unit<1, 8, 1024>(qb, base + C_DQ + hd * 128 + mp * 64, base + C_DK + hd * 128 + mp * 64, base + C_DV + hd * 128 + vhf * 64, ODRAW + rb * 1024 + hd * 256 + mp * 128 + vhf * 64, BT + hd * 256, lds); }
    }
}

__device__ __forceinline__ void phase_combine(const Params& P, int bid, int nblk) {
    int tid_ = threadIdx.x; asm volatile("" : "+v"(tid_)); const int tid = tid_, lane = tid & 63, wave = tid >> 6, nw = NWAVES;
    const int gw = bid * nw + wave, NGW = nblk * nw;
    const float s1 = wave_sum(P.lq1[lane] * P.lk1[lane]), s2 = wave_sum(P.lq2[lane] * P.lk2[lane]);
    const float lam = expf(s1) - expf(s2) + 0.2f;
    bf16_t* PROJ = (bf16_t*)(P.ws + WS_PROJ); const bf16_t* ODRAW = (const bf16_t*)(P.ws + WS_XN);
    const int h = lane >> 4, e0 = (lane & 15) * 8;
    float g[8];
#pragma unroll
    for (int j = 0; j < 8; ++j) g[j] = P.g_subln[e0 + j] * 0.8f;
    for (int m = gw; m < M; m += NGW) {
        const bf16x8 a = *(const bf16x8*)(ODRAW + (size_t)m * 1024 + h * 256 + e0), b = *(const bf16x8*)(ODRAW + (size_t)m * 1024 + h * 256 + 128 + e0);
        float v[8]; float ss = 0.f;
#pragma unroll
        for (int j = 0; j < 8; ++j) { v[j] = bf2f((bf16_t)a[j]) - lam * bf2f((bf16_t)b[j]); ss += v[j] * v[j]; }
        ss += __shfl_xor(ss, 1); ss += __shfl_xor(ss, 2); ss += __shfl_xor(ss, 4); ss += __shfl_xor(ss, 8);
        const float r = 1.0f / sqrtf(ss * (1.f / 128.f) + EPS);
        uint4 o; o.x = pk2(v[0] * r * g[0], v[1] * r * g[1]); o.y = pk2(v[2] * r * g[2], v[3] * r * g[3]); o.z = pk2(v[4] * r * g[4], v[5] * r * g[5]); o.w = pk2(v[6] * r * g[6], v[7] * r * g[7]);
        *(uint4*)(PROJ + (size_t)m * NP + C_OD + h * 128 + e0) = o;
    }
}

__device__ __forceinline__ void phase_norm2(const Params& P, int bid, int nblk) {
    int tid_ = threadIdx.x; asm volatile("" : "+v"(tid_)); const int tid = tid_, lane = tid & 63, wave = tid >> 6, nw = NWAVES;
    const int gw = bid * nw + wave, NGW = nblk * nw;
    for (int m = gw; m < M; m += NGW) norm_row(P.out + (size_t)m * DM, P.g_mlp, (bf16_t*)(P.ws + WS_XN) + (size_t)m * DM, nullptr, nullptr, nullptr, lane);
}
__device__ __forceinline__ void phase_final(const Params& P, int bid, int nblk) {
    int tid_ = threadIdx.x; asm volatile("" : "+v"(tid_)); const int tid = tid_, lane = tid & 63, wave = tid >> 6, nw = NWAVES;
    const int gw = bid * nw + wave, NGW = nblk * nw;
    for (int m = gw; m < M; m += NGW) {
        float* row = P.out + (size_t)m * DM; f32x4 v[4]; float s = 0.f;
#pragma unroll
        for (int j = 0; j < 4; ++j) { v[j] = *(const f32x4*)(row + 4 * lane + 256 * j); s += (v[j].x * v[j].x + v[j].y * v[j].y) + (v[j].z * v[j].z + v[j].w * v[j].w); }
        const float r = 1.0f / sqrtf(wave_sum(s) * (1.f / DM) + EPS);
#pragma unroll
        for (int j = 0; j < 4; ++j) { const f32x4 gg = *(const f32x4*)(P.g_final + 4 * lane + 256 * j); f32x4 y; y.x = v[j].x * r * gg.x; y.y = v[j].y * r * gg.y; y.z = v[j].z * r * gg.z; y.w = v[j].w * r * gg.w;
            *(f32x4*)(row + 4 * lane + 256 * j) = y; }
    }
}

__global__ void __launch_bounds__(NTHREADS, 2) fwd_mega(Params P) {
    extern __shared__ __attribute__((aligned(16))) unsigned char lds_raw[];
    LAS unsigned char* lds = (LAS unsigned char*)lds_raw;
    cg::grid_group grid = cg::this_grid();
    const int bid = blockIdx.x, G = gridDim.x;
    bf16_t* PROJ = (bf16_t*)(P.ws + WS_PROJ); bf16_t* XN = (bf16_t*)(P.ws + WS_XN);
#define GRID_BAR() grid.sync()
    phase_prologue(P, lds, bid, G);
    GRID_BAR();
    phase_cumsum(P, bid, G);
    { pg8::Gemm g{XN, (const bf16_t*)(P.ws + WS_WIN), M, NP, 1024, 1024, 1024}; pg8::StaticOrder S; S.init(M, NP, G, bid);
      pg8::EpiProj E{PROJ}; pg8::gemm_phase<pg8::EpiProj, pg8::StaticOrder, PG8_ALIGN, PG8_SP2>(lds, g, S, E); }
    GRID_BAR();
    phase_attention(P, (char*)lds_raw, bid, G);
    GRID_BAR();
    phase_combine(P, bid, G);
    GRID_BAR();
    { pg8::Gemm g{PROJ + C_OD, (const bf16_t*)(P.ws + WS_WPA), M, 1024, 512, NP, 512}; pg8::StaticOrder S; S.init(M, 1024, G, bid);
      pg8::EpiGate E{PROJ, C_G0, -1, C_T1}; pg8::gemm_phase<pg8::EpiGate, pg8::StaticOrder, PG8_ALIGN, PG8_SP2>(lds, g, S, E); }
    GRID_BAR();
    { pg8::Gemm g{PROJ + C_OF, (const bf16_t*)(P.ws + WS_WPB), M, 1024, 512, NP, 512}; pg8::StaticOrder S; S.init(M, 1024, G, bid);
      pg8::EpiGate E{PROJ, C_G1, C_T1, C_MRG}; pg8::gemm_phase<pg8::EpiGate, pg8::StaticOrder, PG8_ALIGN, PG8_SP2>(lds, g, S, E); }
    GRID_BAR();
    { pg8::Gemm g{PROJ + C_MRG, (const bf16_t*)(P.ws + WS_WO), M, 1024, 1024, NP, 1024}; pg8::StaticOrder S; S.init(M, 1024, G, bid);
      pg8::EpiResF32 E{P.x, P.out}; pg8::gemm_phase<pg8::EpiResF32, pg8::StaticOrder, PG8_ALIGN, PG8_SP2>(lds, g, S, E); }
    GRID_BAR();
    phase_norm2(P, bid, G);
    GRID_BAR();
    { pg8::Gemm g{XN, (const bf16_t*)(P.ws + WS_W1), M, FF, 1024, 1024, 1024}; pg8::StaticOrder S; S.init(M, FF, G, bid);
      pg8::EpiRelu2 E{PROJ, FF}; pg8::gemm_phase<pg8::EpiRelu2, pg8::StaticOrder, PG8_ALIGN, PG8_SP2>(lds, g, S, E); }
    GRID_BAR();
    { pg8::Gemm g{PROJ, (const bf16_t*)(P.ws + WS_W2), M, 1024, FF, FF, FF}; pg8::StaticOrder S; S.init(M, 1024, G, bid);
      pg8::EpiResF32 E{P.out, P.out}; pg8::gemm_phase<pg8::EpiResF32, pg8::StaticOrder, PG8_ALIGN, PG8_SP2>(lds, g, S, E); }
    GRID_BAR();
    phase_final(P, bid, G);
}

extern "C" void kernel_launch(void* const* d_in, const int* in_sizes, int n_in, void* d_out, int out_size, void* d_ws, size_t ws_size, hipStream_t stream) {
    if (n_in != 17 || out_size != M * DM || ws_size < WS_END) { fprintf(stderr, "kernel_launch: unexpected shapes n_in %d out %d ws %zu\n", n_in, out_size, ws_size); return; }
    Params P{};
    P.x = (const float*)d_in[0]; P.g_mix = (const float*)d_in[1]; P.w_in = (const float*)d_in[2]; P.b_f = (const float*)d_in[3];
    P.lq1 = (const float*)d_in[4]; P.lk1 = (const float*)d_in[5]; P.lq2 = (const float*)d_in[6]; P.lk2 = (const float*)d_in[7];
    P.g_subln = (const float*)d_in[8]; P.w_pa = (const float*)d_in[9]; P.w_pb = (const float*)d_in[10]; P.w_o = (const float*)d_in[11];
    P.g_mlp = (const float*)d_in[12]; P.w_1 = (const float*)d_in[13]; P.w_2 = (const float*)d_in[14]; P.rel_table = (const float*)d_in[15]; P.g_final = (const float*)d_in[16];
    P.out = (float*)d_out; P.ws = (unsigned char*)d_ws;
    static int grid_blocks = 0;
    if (!grid_blocks) { int dev = 0, cus = 0, per_cu = 0; hipGetDevice(&dev); hipDeviceGetAttribute(&cus, hipDeviceAttributeMultiprocessorCount, dev);
        if (hipFuncSetAttribute((const void*)fwd_mega, hipFuncAttributeMaxDynamicSharedMemorySize, LDS_BYTES) != hipSuccess) fprintf(stderr, "kernel_launch: hipFuncSetAttribute failed\n");
        hipOccupancyMaxActiveBlocksPerMultiprocessor(&per_cu, fwd_mega, NTHREADS, LDS_BYTES);
        if (per_cu < 1) { fprintf(stderr, "kernel_launch: occupancy query says %d blocks per CU\n", per_cu); per_cu = 1; }
        (void)hipGetLastError();
        grid_blocks = cus;
    }
    void* args[] = {&P};
    hipError_t e = hipLaunchCooperativeKernel((void*)fwd_mega, dim3(grid_blocks), dim3(NTHREADS), args, LDS_BYTES, stream);
    if (e != hipSuccess) fprintf(stderr, "cooperative launch failed: %s (grid %d)\n", hipGetErrorString(e), grid_blocks);
}
```

```cpp
#include <hip/hip_runtime.h>
#include <hip/hip_cooperative_groups.h>
#include <hip/hip_bf16.h>
#include <cstdio>
#include <cstdint>
namespace cg = cooperative_groups;
namespace pg8 {
#define PG8_LAS __attribute__((address_space(3)))
typedef unsigned short bf16_t;
typedef short bf16x8 __attribute__((ext_vector_type(8)));
typedef float f32x4 __attribute__((ext_vector_type(4)));
typedef unsigned u32x4 __attribute__((ext_vector_type(4)));
constexpr int BM = 256, BK = 64, HALF = 128, HTB = HALF * BK * 2  , STAGE_BYTES = 8 * HTB, NXCD = 8, WGM = 8;

__host__ __device__ __forceinline__ int lds_byte(int r, int c) { const int st = (r >> 4) * 2 + (c >> 5), rr = r & 15, cc = c & 31, ob = rr * 64 + cc * 2; return st * 1024 + (ob ^ (((ob >> 9) & 1) << 5)); }
__host__ __device__ __forceinline__ void stage_rc(int b, int& R, int& C) { const int st = b / 1024, sb = b % 1024, swz = sb ^ (((sb >> 9) & 1) << 5); R = (st >> 1) * 16 + swz / 64; C = (st & 1) * 32 + (swz % 64) / 2; }
__host__ __device__ __forceinline__ int perm32(int rho) { const int n = rho >> 4, i = rho & 15; return 8 * (i >> 2) + 4 * n + (i & 3); }

struct Unit { int pm, pn; };
struct Gemm { const bf16_t* A; const bf16_t* Bt; int M, N, K, lda, ldb; };

struct StaticOrder {
    int nM, nN, nwg, G, c;
    __host__ __device__ void init(int M, int N, int G_, int c_) { nM = M / BM; nN = N / BM; nwg = nM * nN; G = G_; c = c_; }
    __host__ __device__ bool next(int i, Unit& u) const {
        const long L = (long)i * G + c; if (L >= nwg) return false;
        int wgid = (int)L; { const int q = nwg / NXCD, r = nwg % NXCD, xcd = wgid % NXCD, off = wgid / NXCD; wgid = (xcd < r ? xcd * (q + 1) : r * (q + 1) + (xcd - r) * q) + off; }
        const int nig = WGM * nN, gid = wgid / nig, fm = gid * WGM, gsz = (nM - fm) < WGM ? (nM - fm) : WGM;
        u.pm = fm + ((wgid % nig) % gsz); u.pn = (wgid % nig) / gsz; return true;
    }
    __device__ __forceinline__ void a_ready(const Unit&) const {}
    __device__ __forceinline__ void done(const Unit&) const {}
};


__device__ __forceinline__ unsigned cvt_pk_bf16(float lo, float hi) { unsigned r; asm volatile("v_cvt_pk_bf16_f32 %0, %1, %2" : "=v"(r) : "v"(lo), "v"(hi)); return r; }
__device__ __forceinline__ float bflo(unsigned w) { return __builtin_bit_cast(float, w << 16); }
__device__ __forceinline__ float bfhi(unsigned w) { return __builtin_bit_cast(float, w & 0xffff0000u); }
constexpr int PROJ_LD = 5120;
constexpr float EPI_C2 = 0.125f * 1.4426950408889634f;
struct EpiProj {
    static constexpr bool PERM = true, AFTER_DRAIN = false;
    bf16_t* O;
    __device__ __forceinline__ void operator()(const f32x4 (&acc)[2][2][4][2], const Unit& u, int wr, int wc, int fr, int fq) const {
        const int row0 = u.pm * BM + wr * 64 + fr, col0 = u.pn * BM + wc * 32 + 8 * fq;
        const bool gate = u.pn >= 12; const float sc = (u.pn < 2 || (u.pn >= 6 && u.pn < 8)) ? EPI_C2 : 1.0f;
#pragma unroll
        for (int ai = 0; ai < 2; ++ai)
#pragma unroll
            for (int m = 0; m < 4; ++m) { bf16_t* rowp = O + (size_t)(row0 + ai * HALF + m * 16) * PROJ_LD + col0;
#pragma unroll
                for (int bj = 0; bj < 2; ++bj) { f32x4 v0 = acc[ai][bj][m][0], v1 = acc[ai][bj][m][1];
                    if (gate) {
#pragma unroll
                        for (int e = 0; e < 4; ++e) { v0[e] = __builtin_amdgcn_rcpf(1.0f + __expf(-v0[e])); v1[e] = __builtin_amdgcn_rcpf(1.0f + __expf(-v1[e])); }
                    } else { v0 = v0 * sc; v1 = v1 * sc; }
                    u32x4 w; w.x = cvt_pk_bf16(v0[0], v0[1]); w.y = cvt_pk_bf16(v0[2], v0[3]); w.z = cvt_pk_bf16(v1[0], v1[1]); w.w = cvt_pk_bf16(v1[2], v1[3]);
                    *(u32x4*)(rowp + bj * HALF) = w; } }
    }
};
struct EpiGate {
    static constexpr bool PERM = true, AFTER_DRAIN = false;
    bf16_t* P; int c_gate, c_add, c_out;
    __device__ __forceinline__ void operator()(const f32x4 (&acc)[2][2][4][2], const Unit& u, int wr, int wc, int fr, int fq) const {
        const int row0 = u.pm * BM + wr * 64 + fr, col0 = u.pn * BM + wc * 32 + 8 * fq;
#pragma unroll
        for (int ai = 0; ai < 2; ++ai)
#pragma unroll
            for (int m = 0; m < 4; ++m) { bf16_t* rowp = P + (size_t)(row0 + ai * HALF + m * 16) * PROJ_LD + col0;
#pragma unroll
                for (int bj = 0; bj < 2; ++bj) { const f32x4 v0 = acc[ai][bj][m][0], v1 = acc[ai][bj][m][1];
                    const u32x4 g = *(const u32x4*)(rowp + c_gate + bj * HALF);
                    float o[8] = {v0[0] * bflo(g.x), v0[1] * bfhi(g.x), v0[2] * bflo(g.y), v0[3] * bfhi(g.y), v1[0] * bflo(g.z), v1[1] * bfhi(g.z), v1[2] * bflo(g.w), v1[3] * bfhi(g.w)};
                    if (c_add >= 0) { const u32x4 a = *(const u32x4*)(rowp + c_add + bj * HALF);
                        o[0] += bflo(a.x); o[1] += bfhi(a.x); o[2] += bflo(a.y); o[3] += bfhi(a.y); o[4] += bflo(a.z); o[5] += bfhi(a.z); o[6] += bflo(a.w); o[7] += bfhi(a.w); }
                    u32x4 w; w.x = cvt_pk_bf16(o[0], o[1]); w.y = cvt_pk_bf16(o[2], o[3]); w.z = cvt_pk_bf16(o[4], o[5]); w.w = cvt_pk_bf16(o[6], o[7]);
                    *(u32x4*)(rowp + c_out + bj * HALF) = w; } }
    }
};
struct EpiResF32 {
    static constexpr bool PERM = false, AFTER_DRAIN = false;
    const float* base; float* out;
    __device__ __forceinline__ void operator()(const f32x4 (&acc)[2][2][4][2], const Unit& u, int wr, int wc, int fr, int fq) const {
        const int row0 = u.pm * BM + wr * 64 + fr, col0 = u.pn * BM + wc * 32 + 4 * fq;
#pragma unroll
        for (int ai = 0; ai < 2; ++ai)
#pragma unroll
            for (int m = 0; m < 4; ++m) { const size_t off = (size_t)(row0 + ai * HALF + m * 16) * 1024 + col0;
#pragma unroll
                for (int bj = 0; bj < 2; ++bj)
#pragma unroll
                    for (int n = 0; n < 2; ++n) { const f32x4 b = *(const f32x4*)(base + off + bj * HALF + n * 16); *(f32x4*)(out + off + bj * HALF + n * 16) = b + acc[ai][bj][m][n]; } }
    }
};
struct EpiRelu2 {
    static constexpr bool PERM = true, AFTER_DRAIN = false;
    bf16_t* O; int ldc;
    __device__ __forceinline__ void operator()(const f32x4 (&acc)[2][2][4][2], const Unit& u, int wr, int wc, int fr, int fq) const {
        const int row0 = u.pm * BM + wr * 64 + fr, col0 = u.pn * BM + wc * 32 + 8 * fq;
#pragma unroll
        for (int ai = 0; ai < 2; ++ai)
#pragma unroll
            for (int m = 0; m < 4; ++m) { bf16_t* rowp = O + (size_t)(row0 + ai * HALF + m * 16) * ldc + col0;
#pragma unroll
                for (int bj = 0; bj < 2; ++bj) { f32x4 v0 = acc[ai][bj][m][0], v1 = acc[ai][bj][m][1];
#pragma unroll
                    for (int e = 0; e < 4; ++e) { const float a = fmaxf(v0[e], 0.f), b = fmaxf(v1[e], 0.f); v0[e] = a * a; v1[e] = b * b; }
                    u32x4 w; w.x = cvt_pk_bf16(v0[0], v0[1]); w.y = cvt_pk_bf16(v0[2], v0[3]); w.z = cvt_pk_bf16(v1[0], v1[1]); w.w = cvt_pk_bf16(v1[2], v1[3]);
                    *(u32x4*)(rowp + bj * HALF) = w; } }
    }
};


struct EpiX1 {
    static constexpr bool PERM = false, AFTER_DRAIN = false;
    const float* base; float* out; bf16_t* xb; float* ss;
    __device__ __forceinline__ void operator()(const f32x4 (&acc)[2][2][4][2], const Unit& u, int wr, int wc, int fr, int fq) const {
        typedef unsigned u32x2 __attribute__((ext_vector_type(2)));
        const int row0 = u.pm * BM + wr * 64 + fr, col0 = u.pn * BM + wc * 32 + 4 * fq;
#pragma unroll
        for (int ai = 0; ai < 2; ++ai)
#pragma unroll
            for (int m = 0; m < 4; ++m) { const int row = row0 + ai * HALF + m * 16; const size_t off = (size_t)row * 1024 + col0; float s = 0.f;
#pragma unroll
                for (int bj = 0; bj < 2; ++bj)
#pragma unroll
                    for (int n = 0; n < 2; ++n) { const f32x4 b = *(const f32x4*)(base + off + bj * HALF + n * 16); const f32x4 v = b + acc[ai][bj][m][n];
                        *(f32x4*)(out + off + bj * HALF + n * 16) = v; s += (v[0] * v[0] + v[1] * v[1]) + (v[2] * v[2] + v[3] * v[3]);
                        u32x2 w; w.x = cvt_pk_bf16(v[0], v[1]); w.y = cvt_pk_bf16(v[2], v[3]); *(u32x2*)(xb + off + bj * HALF + n * 16) = w; }
                s += __shfl_xor(s, 16); s += __shfl_xor(s, 32);
                if (fq == 0) ss[(size_t)row * 16 + 4 * u.pn + wc] = s; }
    }
};
struct EpiRelu2N {
    static constexpr bool PERM = true, AFTER_DRAIN = false;
    bf16_t* O; int ldc; const float* ss;
    __device__ __forceinline__ void operator()(const f32x4 (&acc)[2][2][4][2], const Unit& u, int wr, int wc, int fr, int fq) const {
        const int row0 = u.pm * BM + wr * 64 + fr, col0 = u.pn * BM + wc * 32 + 8 * fq;
#pragma unroll
        for (int ai = 0; ai < 2; ++ai)
#pragma unroll
            for (int m = 0; m < 4; ++m) { const int row = row0 + ai * HALF + m * 16; bf16_t* rowp = O + (size_t)row * ldc + col0;
                const f32x4* sp = (const f32x4*)(ss + (size_t)row * 16); const f32x4 s0 = sp[0], s1 = sp[1], s2 = sp[2], s3 = sp[3];
                const float tot = ((s0[0] + s0[1]) + (s0[2] + s0[3])) + ((s1[0] + s1[1]) + (s1[2] + s1[3])) + ((s2[0] + s2[1]) + (s2[2] + s2[3])) + ((s3[0] + s3[1]) + (s3[2] + s3[3]));
                const float r = 1.0f / sqrtf(tot * (1.0f / 1024.0f) + 1e-6f);
#pragma unroll
                for (int bj = 0; bj < 2; ++bj) { f32x4 v0 = acc[ai][bj][m][0], v1 = acc[ai][bj][m][1];
#pragma unroll
                    for (int e = 0; e < 4; ++e) { const float a = fmaxf(v0[e] * r, 0.f), b = fmaxf(v1[e] * r, 0.f); v0[e] = a * a; v1[e] = b * b; }
                    u32x4 w; w.x = cvt_pk_bf16(v0[0], v0[1]); w.y = cvt_pk_bf16(v0[2], v0[3]); w.z = cvt_pk_bf16(v1[0], v1[1]); w.w = cvt_pk_bf16(v1[2], v1[3]);
                    *(u32x4*)(rowp + bj * HALF) = w; } }
    }
};
template <class Epi, class Sched, bool ALIGN_EPI = false, bool SP2 = false>
__device__ __forceinline__ void gemm_phase(PG8_LAS unsigned char* lds, const Gemm g, const Sched& S, const Epi& E) {
    int tid_ = threadIdx.x; asm volatile("" : "+v"(tid_));
    const int tid = tid_, wid = __builtin_amdgcn_readfirstlane(tid >> 6), lane = tid & 63, wr = wid >> 2, wc = wid & 3, fr = lane & 15, fq = lane >> 4;
    const int K = g.K, nt = K / BK;
    unsigned voffA[2], voffB[2];
#pragma unroll
    for (int i = 0; i < 2; ++i) { int R, C; stage_rc(tid * 16 + i * 8192, R, C); const int Rb = Epi::PERM ? ((R & ~31) + perm32(R & 31)) : R;
        voffA[i] = (unsigned)(R * g.lda + C) * 2u; voffB[i] = (unsigned)(Rb * g.ldb + C) * 2u; }
    const size_t kstep = (size_t)(BK * 2);
    const size_t hstepA = (size_t)HALF * g.lda * 2, hstepB = (size_t)HALF * g.ldb * 2;
    const size_t tstepA = 2 * hstepA, tstepB = 2 * hstepB;
    const unsigned ldsw = (unsigned)wid * 1024u;
    const int aoff = lds_byte(wr * 64 + fr, fq * 8), boff = lds_byte(wc * 32 + fr, fq * 8);
#define PG8_SA(b, h) (((b) * 2 + (h)) * HTB)
#define PG8_SB(b, h) ((4 + (b) * 2 + (h)) * HTB)
#define PG8_STAGE(bufoff, gbase, voff) do { _Pragma("unroll") for (int _i = 0; _i < 2; ++_i) \
        __builtin_amdgcn_global_load_lds((const unsigned*)((const char*)(gbase) + (voff)[_i]), (PG8_LAS unsigned*)(lds + (bufoff) + ldsw + _i * 8192), 16, 0, 0); } while (0)
#define PG8_LDA(dst, b, h) do { _Pragma("unroll") for (int m = 0; m < 4; ++m) _Pragma("unroll") for (int k = 0; k < 2; ++k) dst[m][k] = *(const PG8_LAS bf16x8*)(lds + PG8_SA(b, h) + aoff + m * 2048 + k * 1024); } while (0)
#define PG8_LDB(dst, b, h) do { _Pragma("unroll") for (int n = 0; n < 2; ++n) _Pragma("unroll") for (int k = 0; k < 2; ++k) dst[n][k] = *(const PG8_LAS bf16x8*)(lds + PG8_SB(b, h) + boff + n * 2048 + k * 1024); } while (0)
#define PG8_MMA(ai, bj, At, Bt) do { __builtin_amdgcn_s_setprio(1); _Pragma("unroll") for (int m = 0; m < 4; ++m) _Pragma("unroll") for (int n = 0; n < 2; ++n) _Pragma("unroll") for (int k = 0; k < 2; ++k) \
        acc[ai][bj][m][n] = __builtin_amdgcn_mfma_f32_16x16x32_bf16(Bt[n][k], At[m][k], acc[ai][bj][m][n], 0, 0, 0); __builtin_amdgcn_s_setprio(0); } while (0)
#define PG8_WAIT_V(n) asm volatile("s_waitcnt vmcnt(" #n ")" ::: "memory")
#define PG8_WAIT_L(n) asm volatile("s_waitcnt lgkmcnt(" #n ")" ::: "memory")
#define PG8_BAR __builtin_amdgcn_s_barrier()
#define PG8_SCHED __builtin_amdgcn_sched_barrier(0)
    Unit cur, nxt; int ui = 0;
    if (!S.next(0, cur)) return;
    f32x4 acc[2][2][4][2];
#pragma unroll
    for (int a = 0; a < 2; ++a)
#pragma unroll
        for (int b = 0; b < 2; ++b)
#pragma unroll
            for (int m = 0; m < 4; ++m)
#pragma unroll
                for (int n = 0; n < 2; ++n) acc[a][b][m][n] = (f32x4){0.f, 0.f, 0.f, 0.f};
    bf16x8 At[4][2], B0[2][2], B1[2][2];
    const char* cA = (const char*)g.A + (size_t)cur.pm * tstepA; const char* cB = (const char*)g.Bt + (size_t)cur.pn * tstepB;
    S.a_ready(cur);
    if constexpr (SP2) {
        PG8_STAGE(PG8_SB(0, 0), cB, voffB); PG8_STAGE(PG8_SB(0, 1), cB + hstepB, voffB); PG8_STAGE(PG8_SA(0, 0), cA, voffA); PG8_STAGE(PG8_SA(0, 1), cA + hstepA, voffA);
        if (wr == 1) PG8_BAR;
        PG8_WAIT_V(2); PG8_BAR;
        PG8_STAGE(PG8_SB(1, 0), cB + kstep, voffB); PG8_STAGE(PG8_SA(1, 0), cA + kstep, voffA); PG8_STAGE(PG8_SB(1, 1), cB + hstepB + kstep, voffB);
        PG8_WAIT_V(6); PG8_BAR;
    } else {
        PG8_STAGE(PG8_SB(0, 0), cB, voffB); PG8_STAGE(PG8_SA(0, 0), cA, voffA); PG8_STAGE(PG8_SB(0, 1), cB + hstepB, voffB); PG8_STAGE(PG8_SA(0, 1), cA + hstepA, voffA);
        if (wr == 1) PG8_BAR;
        PG8_WAIT_V(4); PG8_BAR;
        PG8_STAGE(PG8_SB(1, 0), cB + kstep, voffB); PG8_STAGE(PG8_SA(1, 0), cA + kstep, voffA); PG8_STAGE(PG8_SB(1, 1), cB + hstepB + kstep, voffB);
        PG8_WAIT_V(6); PG8_BAR;
    }
    for (;;) {
        const bool has_next = S.next(ui + 1, nxt);
        const char* nA = has_next ? (const char*)g.A + (size_t)nxt.pm * tstepA : cA; const char* nB = has_next ? (const char*)g.Bt + (size_t)nxt.pn * tstepB : cB;
        for (int t = 0; t < nt; t += 2) {
            const bool last = (t == nt - 2);
            const char* a1 = cA + (size_t)(t + 1) * kstep;
            const char* a2 = last ? nA : cA + (size_t)(t + 2) * kstep; const char* b2 = last ? nB : cB + (size_t)(t + 2) * kstep;
            const char* a3 = a2 + kstep; const char* b3 = b2 + kstep;
            if (last && has_next) S.a_ready(nxt);
            if constexpr (SP2) {
            PG8_LDB(B0, 0, 0); PG8_LDB(B1, 0, 1); PG8_SCHED; PG8_LDA(At, 0, 0); PG8_STAGE(PG8_SA(1, 1), a1 + hstepA, voffA);
            PG8_WAIT_V(8); PG8_WAIT_L(0); PG8_BAR; PG8_MMA(0, 0, At, B0); PG8_MMA(0, 1, At, B1); PG8_BAR; PG8_SCHED;
            PG8_LDA(At, 0, 1); PG8_STAGE(PG8_SB(0, 0), b2, voffB); PG8_STAGE(PG8_SB(0, 1), b2 + hstepB, voffB); PG8_STAGE(PG8_SA(0, 0), a2, voffA);
            PG8_WAIT_V(8); PG8_WAIT_L(0); PG8_BAR; PG8_MMA(1, 0, At, B0); PG8_MMA(1, 1, At, B1); PG8_BAR; PG8_SCHED;
            PG8_LDB(B0, 1, 0); PG8_LDB(B1, 1, 1); PG8_SCHED; PG8_LDA(At, 1, 0); PG8_STAGE(PG8_SA(0, 1), a2 + hstepA, voffA);
            PG8_WAIT_V(8); PG8_WAIT_L(0); PG8_BAR; PG8_MMA(0, 0, At, B0); PG8_MMA(0, 1, At, B1); PG8_BAR; PG8_SCHED;
            PG8_LDA(At, 1, 1); PG8_STAGE(PG8_SB(1, 0), b3, voffB); PG8_STAGE(PG8_SB(1, 1), b3 + hstepB, voffB); PG8_STAGE(PG8_SA(1, 0), a3, voffA);
            PG8_WAIT_V(8); PG8_WAIT_L(0); PG8_BAR; PG8_MMA(1, 0, At, B0); PG8_MMA(1, 1, At, B1); PG8_BAR; PG8_SCHED;
            } else {
            PG8_LDB(B0, 0, 0); PG8_SCHED; PG8_LDA(At, 0, 0); PG8_STAGE(PG8_SA(1, 1), a1 + hstepA, voffA);
            PG8_WAIT_L(8); PG8_BAR; PG8_WAIT_L(0); PG8_MMA(0, 0, At, B0); PG8_BAR; PG8_SCHED;
            PG8_LDB(B1, 0, 1); PG8_STAGE(PG8_SB(0, 0), b2, voffB);
            PG8_BAR; PG8_WAIT_L(0); PG8_MMA(0, 1, At, B1); PG8_BAR;
            PG8_LDA(At, 0, 1); PG8_STAGE(PG8_SA(0, 0), a2, voffA);
            PG8_BAR; PG8_WAIT_L(0); PG8_MMA(1, 0, At, B0); PG8_BAR; PG8_SCHED;
            PG8_STAGE(PG8_SB(0, 1), b2 + hstepB, voffB);
            PG8_WAIT_V(6); PG8_BAR; PG8_MMA(1, 1, At, B1); PG8_BAR;
            PG8_LDB(B0, 1, 0); PG8_SCHED; PG8_LDA(At, 1, 0); PG8_STAGE(PG8_SA(0, 1), a2 + hstepA, voffA);
            PG8_WAIT_L(8); PG8_BAR; PG8_WAIT_L(0); PG8_MMA(0, 0, At, B0); PG8_BAR; PG8_SCHED;
            PG8_LDB(B1, 1, 1); PG8_STAGE(PG8_SB(1, 0), b3, voffB);
            PG8_BAR; PG8_WAIT_L(0); PG8_MMA(0, 1, At, B1); PG8_BAR;
            PG8_LDA(At, 1, 1); PG8_STAGE(PG8_SA(1, 0), a3, voffA);
            PG8_BAR; PG8_WAIT_L(0); PG8_MMA(1, 0, At, B0); PG8_BAR; PG8_SCHED;
            PG8_STAGE(PG8_SB(1, 1), b3 + hstepB, voffB);
            PG8_WAIT_V(6); PG8_BAR; PG8_MMA(1, 1, At, B1); PG8_BAR;
            }
        }
        if constexpr (ALIGN_EPI) { if (wr == 0) PG8_BAR; }
        if constexpr (!Epi::AFTER_DRAIN) { E(acc, cur, wr, wc, fr, fq); S.done(cur); }
        if (!has_next) break;
#pragma unroll
        for (int a = 0; a < 2; ++a)
#pragma unroll
            for (int b = 0; b < 2; ++b)
#pragma unroll
                for (int m = 0; m < 4; ++m)
#pragma unroll
                    for (int n = 0; n < 2; ++n) acc[a][b][m][n] = (f32x4){0.f, 0.f, 0.f, 0.f};
        cur = nxt; cA = nA; cB = nB; ++ui;
        if constexpr (ALIGN_EPI) { if (wr == 1) PG8_BAR; }
    }
    PG8_WAIT_V(0);
    if constexpr (!ALIGN_EPI) { if (wr == 0) PG8_BAR; }
    PG8_BAR;
    if constexpr (Epi::AFTER_DRAIN) { E.fused(acc, cur, wr, wc, fr, fq, lds, wid, lane); S.done(cur); }
#undef PG8_SA
#undef PG8_SB
#undef PG8_STAGE
#undef PG8_LDA
#undef PG8_LDB
#undef PG8_MMA
#undef PG8_WAIT_V
#undef PG8_WAIT_L
#undef PG8_BAR
#undef PG8_SCHED
}
}
namespace attn_body {
using bf16=__hip_bfloat16;
using bf16x8=__attribute__((ext_vector_type(8)))short;
using s16x4=__attribute__((ext_vector_type(4)))short;
using f32x16=__attribute__((ext_vector_type(16)))float;
using u32x4=__attribute__((ext_vector_type(4)))unsigned;
using f32x4=__attribute__((ext_vector_type(4)))float;
constexpr int SEQ=2048,D=64,DM=5120;
constexpr int NW=8,QBLK=32,QB=QBLK*NW,KVBLK=64,NQB=SEQ/QB;
constexpr int ATTN_PITCH=DM, ATTN_UNIT_ROWS=QB;
__device__ __forceinline__ int crow(int r,int hi){return (r&3)+8*(r>>2)+4*hi;}
#define SBAR() __builtin_amdgcn_sched_barrier(0)
__device__ __forceinline__ void cmask(f32x16&p0,f32x16&p1,int jb,int qrel,int hi){
  const float NEG=-INFINITY; int kb=64*jb+4*hi;
  #pragma unroll
  for(int r=0;r<16;++r){int kv=kb+(r&3)+8*(r>>2); if(kv>qrel)p0[r]=NEG; if(kv+32>qrel)p1[r]=NEG;}
}

__device__ __forceinline__ void dmask(f32x16&p0,f32x16&p1,int jb,int wid){
  if(jb>(wid>>1)){
    #pragma unroll
    for(int r=0;r<16;++r){p0[r]=-INFINITY;p1[r]=-INFINITY;}
  }
}
template<int MODE> __device__ __forceinline__ f32x16 csel(const f32x16&c,const f32x16&n){ if constexpr(MODE==0) return c; else return n; }

constexpr int NSLOT=3, SLOTB=8192;
constexpr int LDS_K=0, LDS_V=NSLOT*SLOTB, LDS_WS=2*NSLOT*SLOTB, LDS_OST=LDS_WS+NW*64*4, LDS_TAB=LDS_OST+NW*4096, LDS_BYTES=LDS_TAB+8192;
constexpr float C2=0.125f*1.4426950408889634f;
__device__ __forceinline__ void glds16(const void*gsrc,unsigned lds_dst){unsigned keep;
  asm volatile("s_mov_b32 %0, m0\n\ts_mov_b32 m0, %2\n\ts_nop 0\n\tglobal_load_lds_dwordx4 %1, off\n\ts_mov_b32 m0, %0":"=&s"(keep):"v"(gsrc),"s"(lds_dst):"memory");}
__device__ __forceinline__ float max3f(float a,float b,float c){float r;asm("v_max3_f32 %0, %1, %2, %3":"=v"(r):"v"(a),"v"(b),"v"(c));return r;}
__device__ __forceinline__ float max2f(float a,float b){float r;asm("v_max_f32_e32 %0, %1, %2":"=v"(r):"v"(a),"v"(b));return r;}
__device__ __forceinline__ float fadd_s(float a,float b){float r;asm("v_add_f32_e32 %0, %1, %2":"=v"(r):"v"(a),"v"(b));return r;}
__device__ __forceinline__ float fsub_s(float a,float b){float r;asm("v_sub_f32_e32 %0, %1, %2":"=v"(r):"v"(a),"v"(b));return r;}
typedef float f32x2_t __attribute__((ext_vector_type(2))); typedef __bf16 bf16x2_t __attribute__((ext_vector_type(2)));
__device__ __forceinline__ unsigned cvtpk_s(float lo,float hi){f32x2_t v={lo,hi};bf16x2_t b=__builtin_convertvector(v,bf16x2_t);return __builtin_bit_cast(unsigned,b);}
#define WAIT_BAR(N) asm volatile("s_waitcnt vmcnt(" #N ") lgkmcnt(0)\n\ts_barrier":::"memory")

__device__ __forceinline__ void qkt(f32x16&p0,f32x16&p1,const char*Kslot,const bf16x8*qr,const f32x16&c0,const f32x16&c1,int r32,int hi){
  const char*kb=Kslot+hi*1024+r32*16;
  #pragma unroll
  for(int d0=0;d0<4;++d0){
    const bf16x8 b0=*reinterpret_cast<const bf16x8*>(kb+d0*2048);
    const bf16x8 b1=*reinterpret_cast<const bf16x8*>(kb+d0*2048+512);
    if(d0==0){p0=__builtin_amdgcn_mfma_f32_32x32x16_bf16(b0,qr[0],c0,0,0,0);p1=__builtin_amdgcn_mfma_f32_32x32x16_bf16(b1,qr[0],c1,0,0,0);}
    else{p0=__builtin_amdgcn_mfma_f32_32x32x16_bf16(b0,qr[d0],p0,0,0,0);p1=__builtin_amdgcn_mfma_f32_32x32x16_bf16(b1,qr[d0],p1,0,0,0);}}
}
typedef __attribute__((address_space(3))) const char* lds_cptr;
typedef short v4i16_t __attribute__((ext_vector_type(4)));
__device__ __forceinline__ void kload8(bf16x8*kf,lds_cptr kp){
  kf[0]=*(const __attribute__((address_space(3))) bf16x8*)(kp);      kf[1]=*(const __attribute__((address_space(3))) bf16x8*)(kp+512);
  kf[2]=*(const __attribute__((address_space(3))) bf16x8*)(kp+2048); kf[3]=*(const __attribute__((address_space(3))) bf16x8*)(kp+2560);
  kf[4]=*(const __attribute__((address_space(3))) bf16x8*)(kp+4096); kf[5]=*(const __attribute__((address_space(3))) bf16x8*)(kp+4608);
  kf[6]=*(const __attribute__((address_space(3))) bf16x8*)(kp+6144); kf[7]=*(const __attribute__((address_space(3))) bf16x8*)(kp+6656);
}
__device__ __forceinline__ void kload2(bf16x8*kf,lds_cptr kp,int j){ kf[2*j]=*(const __attribute__((address_space(3))) bf16x8*)(kp+j*2048); kf[2*j+1]=*(const __attribute__((address_space(3))) bf16x8*)(kp+j*2048+512); }
__device__ __forceinline__ s16x4 vtr(lds_cptr p){ return __builtin_bit_cast(s16x4,__builtin_amdgcn_ds_read_tr16_b64_v4i16((__attribute__((address_space(3))) v4i16_t*)p)); }
__device__ __forceinline__ float rowmax(const f32x16&p0,const f32x16&p1){
  float a=max3f(p0[0],p0[1],p1[0]),b=max3f(p0[2],p0[3],p1[1]);a=max3f(a,p1[2],p1[3]);
  #pragma unroll
  for(int r=4;r<16;r+=4){a=max3f(a,p0[r],p0[r+1]);b=max3f(b,p0[r+2],p0[r+3]);a=max3f(a,p1[r],p1[r+1]);b=max3f(b,p1[r+2],p1[r+3]);}
  const float m=max2f(a,b);
  auto rr=__builtin_amdgcn_permlane32_swap(__float_as_uint(m),__float_as_uint(m),false,false);
  return max2f(__uint_as_float(rr[0]),__uint_as_float(rr[1]));
}
__device__ __forceinline__ void pv(f32x16*o,int vb,bf16x8 pa0,bf16x8 pa1,bf16x8 pa2,bf16x8 pa3){
  #pragma unroll
  for(int d0=0;d0<2;++d0){s16x4 lo[4],hi[4];
    #pragma unroll
    for(int ks=0;ks<4;++ks){
      asm volatile("ds_read_b64_tr_b16 %0,%1 offset:%c2":"=&v"(lo[ks]):"v"(vb),"i"(d0*4096+ks*1024):"memory");
      asm volatile("ds_read_b64_tr_b16 %0,%1 offset:%c2":"=&v"(hi[ks]):"v"(vb),"i"(d0*4096+ks*1024+512):"memory");}
    asm volatile("s_waitcnt lgkmcnt(0)":::"memory");SBAR();
    #define PK(k) (bf16x8){lo[k][0],lo[k][1],lo[k][2],lo[k][3],hi[k][0],hi[k][1],hi[k][2],hi[k][3]}
    o[d0]=__builtin_amdgcn_mfma_f32_32x32x16_bf16(pa0,PK(0),o[d0],0,0,0);
    o[d0]=__builtin_amdgcn_mfma_f32_32x32x16_bf16(pa1,PK(1),o[d0],0,0,0);
    o[d0]=__builtin_amdgcn_mfma_f32_32x32x16_bf16(pa2,PK(2),o[d0],0,0,0);
    o[d0]=__builtin_amdgcn_mfma_f32_32x32x16_bf16(pa3,PK(3),o[d0],0,0,0);
    #undef PK
  }
}

#ifndef ATTN_STORE16
#define ATTN_STORE16(p,v) (*(u32x4*)(p)=(v))
#endif
template<int MODE,int THRL,int OP> __device__ __forceinline__ void attn_unit(int qb,const bf16*Qh,const bf16*__restrict__ Kh,const bf16*__restrict__ Vh,bf16*Oh,const float*__restrict__ tabsrc,char*shm){
  int tid_=threadIdx.x; asm volatile("":"+v"(tid_)); const int tid=tid_,lane=tid&63,r32=lane&31,hi=lane>>5; const int wid=__builtin_amdgcn_readfirstlane(tid>>6);
  const int q0=qb*QB;
  const bf16*Qw=Qh+(long)(q0+wid*QBLK)*DM;
  const unsigned lds0=(unsigned)(uintptr_t)shm;
  float*wsf=(float*)(shm+LDS_WS)+wid*64;
  const bf16*ksrc=Kh+(long)lane*DM+wid*8;
  const bf16*vsrc=Vh+(long)(16*(wid&3)+(lane>>2))*DM+(wid>>2)*32+(lane&3)*8;
  const unsigned kdst=lds0+LDS_K+wid*1024, vdst=lds0+LDS_V+wid*1024;
  #define DMA_K(t,slot) glds16(ksrc+(long)(t)*KVBLK*DM,(unsigned)__builtin_amdgcn_readfirstlane(kdst+(slot)))
  #define DMA_V(t,slot) glds16(vsrc+(long)(t)*KVBLK*DM,(unsigned)__builtin_amdgcn_readfirstlane(vdst+(slot)))
  const int vb0=(int)(lds0+LDS_V)+((lane>>4)&1)*32+(lane&3)*8+(4*hi+((lane&15)>>2))*64;
  const char*Kbase=shm+LDS_K; bf16x8 kf[8];
  const lds_cptr shm3=(lds_cptr)shm; const lds_cptr kp0=shm3+LDS_K+hi*1024+r32*16; const lds_cptr vp0=shm3+LDS_V+((lane>>4)&1)*32+(lane&3)*8+(4*hi+((lane&15)>>2))*64;
  const int qrel=wid*QBLK+r32;
  const int NT=(q0+QB)/KVBLK;
  float*tab=(float*)(shm+LDS_TAB);
  if(MODE==0){ if(tid<(q0+QB)/4){ const f32x4 v_=*(const f32x4*)(tabsrc+4*tid); ((f32x4*)tab)[tid]=-v_; } }
  else { if(tid<112){ f32x4 v_={0.f,0.f,0.f,0.f}; if(tid>=48)v_=*(const f32x4*)(tabsrc+4*(tid-48)); ((f32x4*)tab)[tid]=v_; } }
  #define CINIT(C0,C1,t) do{ if(MODE==0){ const float*tb_=tab+(t)*64+4*hi; \
      _Pragma("unroll") for(int g_=0;g_<4;++g_){ const f32x4 a_=*(const f32x4*)(tb_+8*g_), b_=*(const f32x4*)(tb_+32+8*g_); \
        _Pragma("unroll") for(int e_=0;e_<4;++e_){ C0[4*g_+e_]=a_[e_]; C1[4*g_+e_]=b_[e_]; } } \
      _Pragma("unroll") for(int r_=0;r_<16;++r_){ C0[r_]-=mhat; C1[r_]-=mhat; } } \
    else { const int jb_=(t)-(NT-4); \
      if(jb_>=-2){ const float*b_=tab+(64*jb_+4*hi-qrel+384); \
        _Pragma("unroll") for(int r_=0;r_<16;++r_){ C0[r_]=b_[(r_&3)+8*(r_>>2)]; C1[r_]=b_[(r_&3)+8*(r_>>2)+32]; } \
        _Pragma("unroll") for(int r_=0;r_<16;++r_){ C0[r_]-=mhat; C1[r_]-=mhat; } } \
      else { _Pragma("unroll") for(int r_=0;r_<16;++r_){ C0[r_]=-mhat; C1[r_]=-mhat; } } } }while(0)
  DMA_K(0,0);DMA_V(0,0);DMA_K(1,SLOTB);
  bf16x8 qr[4];
  #pragma unroll
  for(int d0=0;d0<4;++d0)qr[d0]=*reinterpret_cast<const bf16x8*>(&Qw[(long)r32*DM+d0*16+hi*8]);
  float mhat=0.f,l_reg=0.f;f32x16 o[2];o[0]=f32x16{};o[1]=f32x16{};
  #define CMASK(P0,P1,t) do{int jb_=(t)-(NT-4); if(MODE==0){ if(jb_>=0)cmask(P0,P1,jb_,qrel,hi); } else { if(jb_>=0)dmask(P0,P1,jb_,wid); } }while(0)
  bool resc=false;
  #define START(P0,P1) do{ const float rm=rowmax(P0,P1); resc=false; \
    { const float dl=rm; mhat=fadd_s(mhat,dl); \
      _Pragma("unroll") for(int r=0;r<16;++r){P0[r]=fsub_s(P0[r],dl);P1[r]=fsub_s(P1[r],dl);} \
       } \
    _Pragma("unroll") for(int r=0;r<16;++r)P0[r]=__builtin_amdgcn_exp2f(P0[r]); }while(0)
  #define RESC() do{ if(resc){ asm volatile("s_waitcnt lgkmcnt(0)":::"memory"); \
      _Pragma("unroll") for(int d_=0;d_<2;++d_) _Pragma("unroll") for(int r=0;r<16;++r)o[d_][r]*=wsf[crow(r,hi)]; } }while(0)
  f32x16 pA0,pA1,pB0,pB1;
  int sl_prev=0,sl_cur=0,sl_next=SLOTB;
  #define ROT() do{sl_prev=sl_cur;sl_cur=sl_next;sl_next=(sl_next==(NSLOT-1)*SLOTB)?0:sl_next+SLOTB;}while(0)
  DMA_K(2,2*SLOTB);
  WAIT_BAR(3);
  CINIT(pA0,pA1,0);
  qkt(pA0,pA1,Kbase,qr,pA0,pA1,r32,hi);asm volatile("s_nop 15\n\ts_nop 7":"+v"(pA0),"+v"(pA1));CMASK(pA0,pA1,0);
  START(pA0,pA1);
  _Pragma("unroll") for(int r=0;r<16;++r)pA1[r]=__builtin_amdgcn_exp2f(pA1[r]);
  WAIT_BAR(0);
  DMA_K(3,0);DMA_V(1,SLOTB);
  ROT();
  kload8(kf,kp0+sl_cur);
  WAIT_BAR(2);
  s16x4 vlo[8],vhi[8]; u32x4 pw0,pw1,pw2,pw3;
  #define PKW(P,B) cvtpk_s(P[B],P[B+1])
  #define PAF(k) __builtin_bit_cast(bf16x8,pw##k)
  #define VFR(i) (bf16x8){vlo[i][0],vlo[i][1],vlo[i][2],vlo[i][3],vhi[i][0],vhi[i][1],vhi[i][2],vhi[i][3]}
  #define PIN(x) asm volatile("":"+v"(x))
  #define MX3(a,b,c) __builtin_fmaxf(__builtin_fmaxf((a),(b)),(c))
  #define GAPA(MF,A0,A1,A2,A3,W0,W1,PW) do{ MF; sacc+=A0; sacc+=A1; sacc+=A2; sacc+=A3; PIN(sacc); W0; W1; PIN(PW); SBAR(); }while(0)
  #define EX(v) __builtin_amdgcn_exp2f(v)
  #define GAPB(MF,X,B) do{ MF; X[B]=EX(X[B]); X[B+1]=EX(X[B+1]); X[B+2]=EX(X[B+2]); X[B+3]=EX(X[B+3]); PIN(X); SBAR(); }while(0)
  #define VRD(i) do{ vlo[i]=vtr(vp_+(((i)>>2)*4096+((i)&3)*1024)); vhi[i]=vtr(vp_+(((i)>>2)*4096+((i)&3)*1024+512)); }while(0)
  #define KRD(G,j) do{ if(G){ kload2(kf,kp0+sl_next,j); SBAR(); } }while(0)
  #define STEP(C0,C1,P0,P1,t,GK,GV,GL) do{ CINIT(C0,C1,t); SBAR(); \
    const lds_cptr vp_=vp0+sl_prev; \
    VRD(0); SBAR(); float sacc=(P0[0]+P0[1]); \
    GAPA(C0=__builtin_amdgcn_mfma_f32_32x32x16_bf16(kf[0],qr[0],C0,0,0,0), P0[2],P0[3],P0[4],P0[5],     pw0[0]=PKW(P0,0), pw0[1]=PKW(P0,2), pw0); \
    VRD(4); SBAR(); GAPA(C1=__builtin_amdgcn_mfma_f32_32x32x16_bf16(kf[1],qr[0],C1,0,0,0), P0[6],P0[7],P0[8],P0[9],     pw0[2]=PKW(P0,4), pw0[3]=PKW(P0,6), pw0); \
    VRD(1); SBAR(); GAPA(C0=__builtin_amdgcn_mfma_f32_32x32x16_bf16(kf[2],qr[1],C0,0,0,0),   P0[10],P0[11],P0[12],P0[13], pw1[0]=PKW(P0,8), pw1[1]=PKW(P0,10), pw1); \
    VRD(5); SBAR(); GAPA(C1=__builtin_amdgcn_mfma_f32_32x32x16_bf16(kf[3],qr[1],C1,0,0,0),   P0[14],P0[15],P1[0],P1[1],   pw1[2]=PKW(P0,12),pw1[3]=PKW(P0,14), pw1); \
    VRD(2); SBAR(); GAPA(C0=__builtin_amdgcn_mfma_f32_32x32x16_bf16(kf[4],qr[2],C0,0,0,0),   P1[2],P1[3],P1[4],P1[5],     pw2[0]=PKW(P1,0), pw2[1]=PKW(P1,2), pw2); \
    VRD(6); SBAR(); GAPA(C1=__builtin_amdgcn_mfma_f32_32x32x16_bf16(kf[5],qr[2],C1,0,0,0),   P1[6],P1[7],P1[8],P1[9],     pw2[2]=PKW(P1,4), pw2[3]=PKW(P1,6), pw2); \
    VRD(3); SBAR(); GAPA(C0=__builtin_amdgcn_mfma_f32_32x32x16_bf16(kf[6],qr[3],C0,0,0,0),   P1[10],P1[11],P1[12],P1[13], pw3[0]=PKW(P1,8), pw3[1]=PKW(P1,10), pw3); \
    VRD(7); SBAR(); GAPA(C1=__builtin_amdgcn_mfma_f32_32x32x16_bf16(kf[7],qr[3],C1,0,0,0),   P1[14],P1[15],0.f,0.f,       pw3[2]=PKW(P1,12),pw3[3]=PKW(P1,14), pw3); \
    l_reg+=sacc; \
    if(GK){DMA_K((t)+3,sl_cur);} if(GV){DMA_V((t)+1,sl_next);} \
    CMASK(C0,C1,t); \
    { float a=MX3(C0[0],C0[1],C1[0]),b=MX3(C0[2],C0[3],C1[1]); a=MX3(a,C1[2],C1[3]); \
      _Pragma("unroll") for(int r=4;r<16;r+=4){a=MX3(a,C0[r],C0[r+1]);b=MX3(b,C0[r+2],C0[r+3]);a=MX3(a,C1[r],C1[r+1]);b=MX3(b,C1[r+2],C1[r+3]);} \
      float rm=__builtin_fmaxf(a,b); { auto rr=__builtin_amdgcn_permlane32_swap(__float_as_uint(rm),__float_as_uint(rm),false,false); rm=__builtin_fmaxf(__uint_as_float(rr[0]),__uint_as_float(rr[1])); } \
      resc=false; \
      if(__builtin_expect(__any(rm>(float)THRL),0)){ const float dl=__builtin_fmaxf(rm,0.f); mhat+=dl; \
        _Pragma("unroll") for(int r=0;r<16;++r){C0[r]-=dl;C1[r]-=dl;} \
         \
        const float f=__builtin_amdgcn_exp2f(-dl); l_reg*=f; if(hi==0)wsf[r32]=f; resc=true; } } \
    SBAR(); \
    GAPB(o[0]=__builtin_amdgcn_mfma_f32_32x32x16_bf16(PAF(0),VFR(0),o[0],0,0,0), C0,0); \
    GAPB(o[1]=__builtin_amdgcn_mfma_f32_32x32x16_bf16(PAF(0),VFR(4),o[1],0,0,0), C0,4); \
    KRD(GL,0); GAPB(o[0]=__builtin_amdgcn_mfma_f32_32x32x16_bf16(PAF(1),VFR(1),o[0],0,0,0), C0,8); \
    KRD(GL,1); GAPB(o[1]=__builtin_amdgcn_mfma_f32_32x32x16_bf16(PAF(1),VFR(5),o[1],0,0,0), C0,12); \
    KRD(GL,2); GAPB(o[0]=__builtin_amdgcn_mfma_f32_32x32x16_bf16(PAF(2),VFR(2),o[0],0,0,0), C1,0); \
    KRD(GL,3); GAPB(o[1]=__builtin_amdgcn_mfma_f32_32x32x16_bf16(PAF(2),VFR(6),o[1],0,0,0), C1,4); \
    GAPB(o[0]=__builtin_amdgcn_mfma_f32_32x32x16_bf16(PAF(3),VFR(3),o[0],0,0,0), C1,8); \
    GAPB(o[1]=__builtin_amdgcn_mfma_f32_32x32x16_bf16(PAF(3),VFR(7),o[1],0,0,0), C1,12); \
    }while(0)
  int t=1;
  #undef CMASK
  #define CMASK(P0,P1,t) do{}while(0)
  for(;t+7<NT;t+=2){
    STEP(pB0,pB1,pA0,pA1,t,true,true,true);     WAIT_BAR(2); RESC(); ROT();
    STEP(pA0,pA1,pB0,pB1,t+1,true,true,true);   WAIT_BAR(2); RESC(); ROT();
  }
  #undef CMASK
  #define CMASK(P0,P1,t) do{int jb_=(t)-(NT-4); if(MODE==0){ if(jb_>=0)cmask(P0,P1,jb_,qrel,hi); } else { if(jb_>=0)dmask(P0,P1,jb_,wid); } }while(0)
  #define ENDW(tt) do{ if((tt)+3<NT){WAIT_BAR(2);} else if((tt)+2<NT){WAIT_BAR(1);} else {WAIT_BAR(0);} }while(0)
  for(;t+1<NT;t+=2){
    STEP(pB0,pB1,pA0,pA1,t,(t+3<NT),(t+1<NT),(t+1<NT));       ENDW(t);   RESC(); ROT();
    STEP(pA0,pA1,pB0,pB1,t+1,(t+4<NT),(t+2<NT),(t+2<NT));     ENDW(t+1); RESC(); ROT();
  }
  STEP(pB0,pB1,pA0,pA1,NT-1,false,false,false); RESC();
  { float sacc=pB0[0]+pB0[1]; _Pragma("unroll") for(int r=2;r<16;++r)sacc+=pB0[r]; _Pragma("unroll") for(int r=0;r<16;++r)sacc+=pB1[r]; l_reg+=sacc;
    pw0=(u32x4){PKW(pB0,0),PKW(pB0,2),PKW(pB0,4),PKW(pB0,6)};pw1=(u32x4){PKW(pB0,8),PKW(pB0,10),PKW(pB0,12),PKW(pB0,14)};pw2=(u32x4){PKW(pB1,0),PKW(pB1,2),PKW(pB1,4),PKW(pB1,6)};pw3=(u32x4){PKW(pB1,8),PKW(pB1,10),PKW(pB1,12),PKW(pB1,14)};
    SBAR(); pv(o,vb0+sl_cur,PAF(0),PAF(1),PAF(2),PAF(3)); }
  #undef PKW
  #undef PAF
  #undef VFR
  #undef PIN
  #undef MX3
  #undef GAPA
  #undef GAPB
  #undef EX
  #undef VRD
  #undef KRD
  #undef STEP
  #undef ENDW
  {auto rr=__builtin_amdgcn_permlane32_swap(__float_as_uint(l_reg),__float_as_uint(l_reg),false,false);l_reg=__uint_as_float(rr[0])+__uint_as_float(rr[1]);}
  if(hi==0)wsf[32+r32]=l_reg;asm volatile("s_waitcnt lgkmcnt(0)":::"memory");
  float rli[16];
  #pragma unroll
  for(int r=0;r<16;++r)rli[r]=__builtin_amdgcn_rcpf(wsf[32+crow(r,hi)]);
  bf16*Ow=Oh+(long)(q0+wid*QBLK)*OP;
  { bf16*stg=(bf16*)(shm+LDS_OST)+wid*2048;
    #pragma unroll
    for(int r=0;r<16;++r){const int orow=crow(r,hi);
      #pragma unroll
      for(int d0=0;d0<2;++d0)stg[orow*64+d0*32+r32]=__float2bfloat16(o[d0][r]*rli[r]);}
    asm volatile("s_waitcnt lgkmcnt(0)":::"memory");
    #pragma unroll
    for(int i=0;i<4;++i){const int row=i*8+(lane>>3),ch=lane&7; const u32x4 v=*(const u32x4*)(stg+row*64+ch*8); ATTN_STORE16(Ow+(long)row*OP+ch*8,v);} }
  asm volatile("s_waitcnt lgkmcnt(0)\n\ts_barrier":::"memory");
  #undef DMA_K
  #undef DMA_V
  #undef CINIT
  #undef CMASK
  #undef START
  #undef RESC
  #undef ROT
}
constexpr int ATTN_LDS_BYTES=LDS_BYTES;
#undef SBAR
#undef WAIT_BAR
}
#ifndef PG8_SP2
#define PG8_SP2 true
#endif
#ifndef PG8_ALIGN
#define PG8_ALIGN true
#endif

typedef unsigned short bf16_t;
typedef short bf16x8 __attribute__((ext_vector_type(8)));
typedef float f32x4 __attribute__((ext_vector_type(4)));
typedef float f32x16 __attribute__((ext_vector_type(16)));
#define LAS __attribute__((address_space(3)))

constexpr int BATCH = 16, SEQ = 2048, DM = 1024, M = BATCH * SEQ, INC = 5128, NP = 5120, FF = 4096;
constexpr float EPS = 1e-6f, LOG2E = 1.4426950408889634f, C2 = 0.125f * LOG2E;
constexpr int C_DQ = 0, C_DK = 512, C_DV = 1024, C_FQ = 1536, C_FK = 2048, C_FV = 2560, C_G0 = 3072, C_G1 = 4096;
constexpr int C_OD = 0, C_MRG = 512, C_OF = 1536, C_T1 = 2048;

constexpr size_t MiB = 1u << 20;
constexpr size_t WS_WIN = 0, WS_WPA = 10 * MiB, WS_WPB = 11 * MiB, WS_WO = 12 * MiB, WS_W1 = 14 * MiB, WS_W2 = 22 * MiB;
constexpr size_t WS_LOGF = 30 * MiB, WS_FC = 31 * MiB, WS_BT = 32 * MiB, WS_CTL = 33 * MiB, WS_XN = 34 * MiB, WS_PROJ = 98 * MiB, WS_SS1 = 418 * MiB, WS_END = 420 * MiB;
constexpr size_t CTL_ZERO_BYTES = 64 * 1024;
constexpr int MISC_OFF = 131072 + 320;
constexpr int NWAVES = 8, NTHREADS = 512;
constexpr int LDS_BYTES = 147456;

struct Params {
    const float* x; const float* g_mix; const float* w_in; const float* b_f; const float* lq1; const float* lk1; const float* lq2; const float* lk2;
    const float* g_subln; const float* w_pa; const float* w_pb; const float* w_o; const float* g_mlp; const float* w_1; const float* w_2; const float* rel_table; const float* g_final;
    float* out; unsigned char* ws;
};

__device__ __forceinline__ unsigned f2bf(float f) { unsigned u = __builtin_bit_cast(unsigned, f); return (u + 0x7fffu + ((u >> 16) & 1u)) >> 16; }
__device__ __forceinline__ unsigned pk2(float lo, float hi) { return f2bf(lo) | (f2bf(hi) << 16); }
__device__ __forceinline__ float bf2f(bf16_t b) { return __builtin_bit_cast(float, (unsigned)b << 16); }
__device__ __forceinline__ float wave_sum(float v) {
#pragma unroll
    for (int o = 1; o < 64; o <<= 1) v += __shfl_xor(v, o);
    return v;
}
__device__ __forceinline__ int crow(int r, int hi) { return (r & 3) + 8 * (r >> 2) + 4 * hi; }

__device__ __forceinline__ void transpose_item(const float* W, int ldw, int K, bf16_t* WT, LAS float* scr, int kb, int nb, int lane, const float* gk = nullptr) {
    const int k0 = 64 * kb, n0 = 32 * nb;
#pragma unroll 8
    for (int i = 0; i < 32; ++i) { const int kk = 2 * i + (lane >> 5); float w_ = W[(size_t)(k0 + kk) * ldw + n0 + (lane & 31)]; if (gk) w_ *= gk[k0 + kk]; scr[kk * 33 + (lane & 31)] = w_; }
    asm volatile("s_waitcnt lgkmcnt(0)" ::: "memory");
    const int c = lane & 7;
#pragma unroll
    for (int j = 0; j < 4; ++j) { const int n = (lane >> 3) + 8 * j; const LAS float* s = scr + (8 * c) * 33 + n;
        uint4 o; o.x = pk2(s[0 * 33], s[1 * 33]); o.y = pk2(s[2 * 33], s[3 * 33]); o.z = pk2(s[4 * 33], s[5 * 33]); o.w = pk2(s[6 * 33], s[7 * 33]);
        *(uint4*)(WT + (size_t)(n0 + n) * K + k0 + 8 * c) = o; }
    asm volatile("s_waitcnt lgkmcnt(0)" ::: "memory");
}

__device__ __forceinline__ int rel_bucket(int rel) {
    const int ret = rel > 0 ? 16 : 0; const int n = rel < 0 ? -rel : rel;
    int v;
    if (n < 8) v = n; else { int lg = (31 - __clz(n * n)) - 6; v = 8 + lg; if (v > 15) v = 15; }
    return ret + v;
}

__device__ __forceinline__ void norm_row(const float* xrow, const float* g, bf16_t* orow, const float* wfl  , const float* b_f, float* logf_row, int lane) {
    f32x4 v[4]; float s = 0.f;
#pragma unroll
    for (int j = 0; j < 4; ++j) { v[j] = *(const f32x4*)(xrow + 4 * lane + 256 * j); s += (v[j].x * v[j].x + v[j].y * v[j].y) + (v[j].z * v[j].z + v[j].w * v[j].w); }
    const float r = 1.0f / sqrtf(wave_sum(s) * (1.f / DM) + EPS);
    float fl[8];
#pragma unroll
    for (int h = 0; h < 8; ++h) fl[h] = 0.f;
#pragma unroll
    for (int j = 0; j < 4; ++j) {
        const f32x4 gg = *(const f32x4*)(g + 4 * lane + 256 * j);
        f32x4 y; y.x = v[j].x * r * gg.x; y.y = v[j].y * r * gg.y; y.z = v[j].z * r * gg.z; y.w = v[j].w * r * gg.w;
        uint2 o; o.x = pk2(y.x, y.y); o.y = pk2(y.z, y.w);
        *(uint2*)(orow + 4 * lane + 256 * j) = o;
        if (wfl) {
#pragma unroll
            for (int e = 0; e < 4; ++e) { const int k = 4 * lane + 256 * j + e; const float yy = y[e];
                const f32x4 w0 = *(const f32x4*)(wfl + (size_t)k * INC), w1 = *(const f32x4*)(wfl + (size_t)k * INC + 4);
                fl[0] += yy * w0.x; fl[1] += yy * w0.y; fl[2] += yy * w0.z; fl[3] += yy * w0.w; fl[4] += yy * w1.x; fl[5] += yy * w1.y; fl[6] += yy * w1.z; fl[7] += yy * w1.w; }
        }
    }
    if (wfl) {
#pragma unroll
        for (int h = 0; h < 8; ++h) fl[h] = wave_sum(fl[h]);
        if (lane < 8) { float z = 0.f;
#pragma unroll
            for (int h = 0; h < 8; ++h) if (lane == h) z = fl[h];
            z += b_f[lane];
            const float ls = fminf(z, 0.f) - log1pf(expf(-fabsf(z)));
            logf_row[lane] = ls; }
    }
}

__device__ __forceinline__ void phase_prologue(const Params& P, LAS unsigned char* lds, int bid, int nblk) {
    int tid_ = threadIdx.x; asm volatile("" : "+v"(tid_)); const int tid = tid_, lane = tid & 63, wave = tid >> 6, nw = NWAVES;
    const int gw = bid * nw + wave, NGW = nblk * nw;
    LAS float* scr = (LAS float*)lds + wave * (64 * 33);
    unsigned char* ws = P.ws;
    constexpr int I_INA = 16 * 96, I_INB = 16 * 64, I_PA = 8 * 32, I_PB = 8 * 32, I_O = 16 * 32, I_1 = 16 * 128, I_2 = 64 * 32;
    constexpr int NITEMS = I_INA + I_INB + I_PA + I_PB + I_O + I_1 + I_2;
    for (int it = gw; it < NITEMS; it += NGW) {
        int r = it;
        if (r < I_INA) { transpose_item(P.w_in, INC, 1024, (bf16_t*)(ws + WS_WIN), scr, r / 96, r % 96, lane); continue; } r -= I_INA;
        if (r < I_INB) { transpose_item(P.w_in + 3080, INC, 1024, (bf16_t*)(ws + WS_WIN) + (size_t)3072 * 1024, scr, r / 64, r % 64, lane); continue; } r -= I_INB;
        if (r < I_PA) { transpose_item(P.w_pa, 1024, 512, (bf16_t*)(ws + WS_WPA), scr, r / 32, r % 32, lane); continue; } r -= I_PA;
        if (r < I_PB) { transpose_item(P.w_pb, 1024, 512, (bf16_t*)(ws + WS_WPB), scr, r / 32, r % 32, lane); continue; } r -= I_PB;
        if (r < I_O) { transpose_item(P.w_o, 1024, 1024, (bf16_t*)(ws + WS_WO), scr, r / 32, r % 32, lane); continue; } r -= I_O;
        if (r < I_1) { transpose_item(P.w_1, 4096, 1024, (bf16_t*)(ws + WS_W1), scr, r / 128, r % 128, lane, P.g_mlp); continue; } r -= I_1;
        transpose_item(P.w_2, 1024, 4096, (bf16_t*)(ws + WS_W2), scr, r / 32, r % 32, lane);
    }
    if (bid == 0) {
        float* BT = (float*)(ws + WS_BT);
        for (int i = tid; i < 4 * 256; i += NTHREADS) { const int h = i >> 8, rel = (i & 255) - 192;
            BT[i] = (P.rel_table[rel_bucket(rel) * 4 + h] - P.rel_table[15 * 4 + h]) * LOG2E; }
    }
    for (int m = gw; m < M; m += NGW)
        norm_row(P.x + (size_t)m * DM, P.g_mix, (bf16_t*)(ws + WS_XN) + (size_t)m * DM, P.w_in + 3072, P.b_f, (float*)(ws + WS_LOGF) + (size_t)m * 8, lane);
}

__device__ __forceinline__ void phase_cumsum(const Params& P, int bid, int nblk) {
    int tid_ = threadIdx.x; asm volatile("" : "+v"(tid_)); const int tid = tid_, lane = tid & 63, wave = tid >> 6, nw = NWAVES;
    const int gw = bid * nw + wave, NGW = nblk * nw;
    const float* LF = (const float*)(P.ws + WS_LOGF); float* FC = (float*)(P.ws + WS_FC);
    for (int seq = gw; seq < BATCH * 8; seq += NGW) {
        const int b = seq >> 3, h = seq & 7;
        const size_t base = ((size_t)b * SEQ + lane * 32) * 8 + h;
        float loc[32]; float run = 0.f;
#pragma unroll
        for (int i = 0; i < 32; ++i) { run += LF[base + (size_t)i * 8]; loc[i] = run; }
        float incl = run;
#pragma unroll
        for (int o = 1; o < 64; o <<= 1) { const float t = __shfl_up(incl, o); if (lane >= o) incl += t; }
        const float excl = incl - run;
#pragma unroll
        for (int i = 0; i < 32; ++i) FC[(size_t)seq * SEQ + lane * 32 + i] = (loc[i] + excl) * LOG2E;
    }
}

__device__ __forceinline__ void phase_attention(const Params& P, char* lds, int bid, int G) {
    const int vcu = (G % 8 == 0) ? (bid % 8) * (G / 8) + bid / 8 : bid;
    const attn_body::bf16* PROJ = (const attn_body::bf16*)(P.ws + WS_PROJ); attn_body::bf16* ODRAW = (attn_body::bf16*)(P.ws + WS_XN);
    const float* FC = (const float*)(P.ws + WS_FC); const float* BT = (const float*)(P.ws + WS_BT);
    for (int c = vcu; c < 256; c += G) {
        const int b = c >> 4, k = c & 15; const size_t rb = (size_t)b * SEQ; const attn_body::bf16* base = PROJ + rb * NP;
        { const int h = k >> 1;
          for (int i = 0; i < 4; ++i) { const int s = 2 * (k & 1) + (i >> 1), qb = (i & 1) ? s : 7 - s;
              attn_body::attn_unit<0, 64, NP>(qb, base + C_FQ + h * 64, base + C_FK + h * 64, base + C_FV + h * 64, (attn_body::bf16*)base + C_OF + h * 64, FC + (size_t)(b * 8 + h) * SEQ, lds); } }
        { const int hd = k >> 2, mp = (k >> 1) & 1, vhf = k & 1;
          for (int qb = 7; qb >= 0; --qb)
              attn_body::attn_unit<1, 8, 1024>(qb, base + C_DQ + hd * 128 + mp * 64, base + C_DK + hd * 128 + mp * 64, base + C_DV + hd * 128 + vhf * 64, ODRAW + rb * 1024 + hd * 256 + mp * 128 + vhf * 64, BT + hd * 256, lds); }
    }
}

__device__ __forceinline__ void phase_combine(const Params& P, int bid, int nblk) {
    int tid_ = threadIdx.x; asm volatile("" : "+v"(tid_)); const int tid = tid_, lane = tid & 63, wave = tid >> 6, nw = NWAVES;
    const int gw = bid * nw + wave, NGW = nblk * nw;
    const float s1 = wave_sum(P.lq1[lane] * P.lk1[lane]), s2 = wave_sum(P.lq2[lane] * P.lk2[lane]);
    const float lam = expf(s1) - expf(s2) + 0.2f;
    bf16_t* PROJ = (bf16_t*)(P.ws + WS_PROJ); const bf16_t* ODRAW = (const bf16_t*)(P.ws + WS_XN);
    const int h = lane >> 4, e0 = (lane & 15) * 8;
    float g[8];
#pragma unroll
    for (int j = 0; j < 8; ++j) g[j] = P.g_subln[e0 + j] * 0.8f;
    for (int m = gw; m < M; m += NGW) {
        const bf16x8 a = *(const bf16x8*)(ODRAW + (size_t)m * 1024 + h * 256 + e0), b = *(const bf16x8*)(ODRAW + (size_t)m * 1024 + h * 256 + 128 + e0);
        float v[8]; float ss = 0.f;
#pragma unroll
        for (int j = 0; j < 8; ++j) { v[j] = bf2f((bf16_t)a[j]) - lam * bf2f((bf16_t)b[j]); ss += v[j] * v[j]; }
        ss += __shfl_xor(ss, 1); ss += __shfl_xor(ss, 2); ss += __shfl_xor(ss, 4); ss += __shfl_xor(ss, 8);
        const float r = 1.0f / sqrtf(ss * (1.f / 128.f) + EPS);
        uint4 o; o.x = pk2(v[0] * r * g[0], v[1] * r * g[1]); o.y = pk2(v[2] * r * g[2], v[3] * r * g[3]); o.z = pk2(v[4] * r * g[4], v[5] * r * g[5]); o.w = pk2(v[6] * r * g[6], v[7] * r * g[7]);
        *(uint4*)(PROJ + (size_t)m * NP + C_OD + h * 128 + e0) = o;
    }
}

__device__ __forceinline__ void phase_norm2(const Params& P, int bid, int nblk) {
    int tid_ = threadIdx.x; asm volatile("" : "+v"(tid_)); const int tid = tid_, lane = tid & 63, wave = tid >> 6, nw = NWAVES;
    const int gw = bid * nw + wave, NGW = nblk * nw;
    for (int m = gw; m < M; m += NGW) norm_row(P.out + (size_t)m * DM, P.g_mlp, (bf16_t*)(P.ws + WS_XN) + (size_t)m * DM, nullptr, nullptr, nullptr, lane);
}
__device__ __forceinline__ void phase_final(const Params& P, int bid, int nblk) {
    int tid_ = threadIdx.x; asm volatile("" : "+v"(tid_)); const int tid = tid_, lane = tid & 63, wave = tid >> 6, nw = NWAVES;
    const int gw = bid * nw + wave, NGW = nblk * nw;
    for (int m = gw; m < M; m += NGW) {
        float* row = P.out + (size_t)m * DM; f32x4 v[4]; float s = 0.f;
#pragma unroll
        for (int j = 0; j < 4; ++j) { v[j] = *(const f32x4*)(row + 4 * lane + 256 * j); s += (v[j].x * v[j].x + v[j].y * v[j].y) + (v[j].z * v[j].z + v[j].w * v[j].w); }
        const float r = 1.0f / sqrtf(wave_sum(s) * (1.f / DM) + EPS);
#pragma unroll
        for (int j = 0; j < 4; ++j) { const f32x4 gg = *(const f32x4*)(P.g_final + 4 * lane + 256 * j); f32x4 y; y.x = v[j].x * r * gg.x; y.y = v[j].y * r * gg.y; y.z = v[j].z * r * gg.z; y.w = v[j].w * r * gg.w;
            *(f32x4*)(row + 4 * lane + 256 * j) = y; }
    }
}

#define XB_TMO      128
#define XB_XCNT(j)  (256  + 64 * (j))
#define XB_XSUB(j)  (1280 + 64 * (j))
#define XB_XGEN(j)  (2304 + 64 * (j))
#define XB_TOP      3328
#define XB_TOPGEN   3392
#define XCD_BAR_WORDS 3456
#define XB_SPIN_CAP (1u << 18)

__device__ __forceinline__ unsigned xb_ld(unsigned* p)              { return __hip_atomic_load(p, __ATOMIC_RELAXED, __HIP_MEMORY_SCOPE_AGENT); }
__device__ __forceinline__ unsigned xb_add(unsigned* p, unsigned v) { return __hip_atomic_fetch_add(p, v, __ATOMIC_RELAXED, __HIP_MEMORY_SCOPE_AGENT); }
__device__ __forceinline__ unsigned xb_xcc_id() { return (unsigned)__builtin_amdgcn_s_getreg((3 << 11) | 20) & 0xFu; }
#define XB_SPIN(cond, bar) do { unsigned _sp = 0; while (cond) { __builtin_amdgcn_s_sleep(1); \
    if ((++_sp & 255u) == 0u) { if (xb_ld(&(bar)[XB_TMO])) break; if (_sp > XB_SPIN_CAP) { atomicAdd(&(bar)[XB_TMO], 1u); break; } } } } while (0)

struct XcdBarrier {
    unsigned* bar; unsigned x;
    volatile LAS unsigned* st;
};

__device__ __forceinline__ XcdBarrier xcd_barrier_post(unsigned* bar, volatile LAS unsigned* st) {
    XcdBarrier b; b.bar = bar; b.x = xb_xcc_id(); b.st = st;
    if (threadIdx.x == 0) (void)xb_add(&bar[XB_XCNT(b.x)], 1u);
    return b;
}
__device__ __forceinline__ void xcd_barrier_complete(unsigned* bar, unsigned x, unsigned& nloc, unsigned& nx) {
    const unsigned G = gridDim.x * gridDim.y * gridDim.z;
    unsigned sum, cnt, mine, sp = 0u;
    for (;;) {
        sum = 0u; cnt = 0u; mine = 0u;
#pragma unroll
        for (unsigned j = 0; j < 16; ++j) { const unsigned c = xb_ld(&bar[XB_XCNT(j)]); sum += c; cnt += (c > 0u) ? 1u : 0u; mine = (j == x) ? c : mine; }
        if (sum == G) break;
        __builtin_amdgcn_s_sleep(1);
        if ((++sp & 255u) == 0u) { if (xb_ld(&bar[XB_TMO])) break; if (sp > XB_SPIN_CAP) { atomicAdd(&bar[XB_TMO], 1u); break; } }
    }
    nloc = mine > 0u ? mine : 1u; nx = cnt > 0u ? cnt : 1u;
}

__device__ __forceinline__ void xcd_barrier(const XcdBarrier& b) {
    asm volatile("s_waitcnt vmcnt(0)" ::: "memory");
    __syncthreads();
    if (threadIdx.x == 0) {
        unsigned* bar = b.bar;
        __builtin_amdgcn_s_waitcnt(0);
        unsigned nloc = b.st[0], nx = b.st[1];
        if (nloc == 0u) { xcd_barrier_complete(bar, b.x, nloc, nx); b.st[0] = nloc; b.st[1] = nx; }
        const unsigned old = xb_add(&bar[XB_XSUB(b.x)], 1u);
        const unsigned gen = old / nloc;
        if (old + 1u == (gen + 1u) * nloc) {
            __builtin_amdgcn_fence(__ATOMIC_RELEASE, "agent");
            asm volatile("s_waitcnt vmcnt(0)" ::: "memory");
            const unsigned og = xb_add(&bar[XB_TOP], 1u);
            const unsigned tg = og / nx;
            if (og + 1u == (tg + 1u) * nx) xb_add(&bar[XB_TOPGEN], 1u);
            else XB_SPIN(xb_ld(&bar[XB_TOPGEN]) == tg, bar);
            __builtin_amdgcn_fence(__ATOMIC_ACQUIRE, "agent");
            xb_add(&bar[XB_XGEN(b.x)], 1u);
            asm volatile("s_waitcnt vmcnt(0)" ::: "memory");
        } else {
            XB_SPIN(xb_ld(&bar[XB_XGEN(b.x)]) == gen, bar);
            __builtin_amdgcn_fence(__ATOMIC_ACQUIRE, "agent");
            asm volatile("s_waitcnt vmcnt(0)" ::: "memory");
        }
    }
    __syncthreads();
}

__global__ void __launch_bounds__(NTHREADS, 2) fwd_mega(Params P) {
    extern __shared__ __attribute__((aligned(16))) unsigned char lds_raw[];
    LAS unsigned char* lds = (LAS unsigned char*)lds_raw;
    const int bid = blockIdx.x, G = gridDim.x;
    bf16_t* PROJ = (bf16_t*)(P.ws + WS_PROJ); bf16_t* XN = (bf16_t*)(P.ws + WS_XN); float* SS1 = (float*)(P.ws + WS_SS1);
    volatile LAS unsigned* MISC = (volatile LAS unsigned*)(lds + MISC_OFF);
    for (int u = threadIdx.x; u < (LDS_BYTES - 131072) / 4; u += NTHREADS) ((LAS unsigned*)(lds + 131072))[u] = 0u;
    __syncthreads();
    cg::grid_group grid = cg::this_grid();
    if (bid == 0) { unsigned* bw = (unsigned*)(P.ws + WS_CTL); for (int u = threadIdx.x; u < XCD_BAR_WORDS; u += NTHREADS) __hip_atomic_store(bw + u, 0u, __ATOMIC_RELAXED, __HIP_MEMORY_SCOPE_AGENT); }
    phase_prologue(P, lds, bid, G);
    grid.sync();
    XcdBarrier bar = xcd_barrier_post((unsigned*)(P.ws + WS_CTL), MISC + 8);
#define GRID_BAR() xcd_barrier(bar)
    phase_cumsum(P, bid, G);
    { pg8::Gemm g{XN, (const bf16_t*)(P.ws + WS_WIN), M, NP, 1024, 1024, 1024}; pg8::StaticOrder S; S.init(M, NP, G, bid);
      pg8::EpiProj E{PROJ}; pg8::gemm_phase<pg8::EpiProj, pg8::StaticOrder, PG8_ALIGN, PG8_SP2>(lds, g, S, E); }
    GRID_BAR();
    phase_attention(P, (char*)lds_raw, bid, G);
    GRID_BAR();
    phase_combine(P, bid, G);
    GRID_BAR();
    { pg8::Gemm g{PROJ + C_OD, (const bf16_t*)(P.ws + WS_WPA), M, 1024, 512, NP, 512}; pg8::StaticOrder S; S.init(M, 1024, G, bid);
      pg8::EpiGate E{PROJ, C_G0, -1, C_T1}; pg8::gemm_phase<pg8::EpiGate, pg8::StaticOrder, PG8_ALIGN, PG8_SP2>(lds, g, S, E); }
    { pg8::Gemm g{PROJ + C_OF, (const bf16_t*)(P.ws + WS_WPB), M, 1024, 512, NP, 512}; pg8::StaticOrder S; S.init(M, 1024, G, bid);
      pg8::EpiGate E{PROJ, C_G1, C_T1, C_MRG}; pg8::gemm_phase<pg8::EpiGate, pg8::StaticOrder, PG8_ALIGN, PG8_SP2>(lds, g, S, E); }
    GRID_BAR();
    { pg8::Gemm g{PROJ + C_MRG, (const bf16_t*)(P.ws + WS_WO), M, 1024, 1024, NP, 1024}; pg8::StaticOrder S; S.init(M, 1024, G, bid);
      pg8::EpiX1 E{P.x, P.out, XN, SS1}; pg8::gemm_phase<pg8::EpiX1, pg8::StaticOrder, PG8_ALIGN, PG8_SP2>(lds, g, S, E); }
    GRID_BAR();
    { pg8::Gemm g{XN, (const bf16_t*)(P.ws + WS_W1), M, FF, 1024, 1024, 1024}; pg8::StaticOrder S; S.init(M, FF, G, bid);
      pg8::EpiRelu2N E{PROJ, FF, SS1}; pg8::gemm_phase<pg8::EpiRelu2N, pg8::StaticOrder, PG8_ALIGN, PG8_SP2>(lds, g, S, E); }
    GRID_BAR();
    { pg8::Gemm g{PROJ, (const bf16_t*)(P.ws + WS_W2), M, 1024, FF, FF, FF}; pg8::StaticOrder S; S.init(M, 1024, G, bid);
      pg8::EpiResF32 E{P.out, P.out}; pg8::gemm_phase<pg8::EpiResF32, pg8::StaticOrder, PG8_ALIGN, PG8_SP2>(lds, g, S, E); }
    GRID_BAR();
    phase_final(P, bid, G);
}

extern "C" void kernel_launch(void* const* d_in, const int* in_sizes, int n_in, void* d_out, int out_size, void* d_ws, size_t ws_size, hipStream_t stream) {
    if (n_in != 17 || out_size != M * DM || ws_size < WS_END) { fprintf(stderr, "kernel_launch: unexpected shapes n_in %d out %d ws %zu\n", n_in, out_size, ws_size); return; }
    Params P{};
    P.x = (const float*)d_in[0]; P.g_mix = (const float*)d_in[1]; P.w_in = (const float*)d_in[2]; P.b_f = (const float*)d_in[3];
    P.lq1 = (const float*)d_in[4]; P.lk1 = (const float*)d_in[5]; P.lq2 = (const float*)d_in[6]; P.lk2 = (const float*)d_in[7];
    P.g_subln = (const float*)d_in[8]; P.w_pa = (const float*)d_in[9]; P.w_pb = (const float*)d_in[10]; P.w_o = (const float*)d_in[11];
    P.g_mlp = (const float*)d_in[12]; P.w_1 = (const float*)d_in[13]; P.w_2 = (const float*)d_in[14]; P.rel_table = (const float*)d_in[15]; P.g_final = (const float*)d_in[16];
    P.out = (float*)d_out; P.ws = (unsigned char*)d_ws;
    static int grid_blocks = 0;
    if (!grid_blocks) { int dev = 0, cus = 0, per_cu = 0; (void)hipGetDevice(&dev); (void)hipDeviceGetAttribute(&cus, hipDeviceAttributeMultiprocessorCount, dev);
        if (hipFuncSetAttribute((const void*)fwd_mega, hipFuncAttributeMaxDynamicSharedMemorySize, LDS_BYTES) != hipSuccess) fprintf(stderr, "kernel_launch: hipFuncSetAttribute failed\n");
        if (hipOccupancyMaxActiveBlocksPerMultiprocessor(&per_cu, fwd_mega, NTHREADS, LDS_BYTES) != hipSuccess || per_cu < 1) fprintf(stderr, "kernel_launch: occupancy query says %d blocks per CU\n", per_cu);
        (void)hipGetLastError();
        grid_blocks = cus;
    }
    void* args[] = {&P};
    hipError_t e = hipLaunchCooperativeKernel((void*)fwd_mega, dim3(grid_blocks), dim3(NTHREADS), args, LDS_BYTES, stream);
    if (e != hipSuccess) fprintf(stderr, "cooperative launch failed: %s (grid %d)\n", hipGetErrorString(e), grid_blocks);
}
```

```cpp
#include <hip/hip_runtime.h>
#include <hip/hip_cooperative_groups.h>
#include <hip/hip_bf16.h>
#include <cstdio>
#include <cstdint>
namespace cg = cooperative_groups;
namespace pg8 {
#define PG8_LAS __attribute__((address_space(3)))
typedef unsigned short bf16_t;
typedef short bf16x8 __attribute__((ext_vector_type(8)));
typedef float f32x4 __attribute__((ext_vector_type(4)));
typedef unsigned u32x4 __attribute__((ext_vector_type(4)));
constexpr int BM = 256, BK = 64, HALF = 128, HTB = HALF * BK * 2  , STAGE_BYTES = 8 * HTB, NXCD = 8, WGM = 8;

__host__ __device__ __forceinline__ int lds_byte(int r, int c) { const int st = (r >> 4) * 2 + (c >> 5), rr = r & 15, cc = c & 31, ob = rr * 64 + cc * 2; return st * 1024 + (ob ^ (((ob >> 9) & 1) << 5)); }
__host__ __device__ __forceinline__ void stage_rc(int b, int& R, int& C) { const int st = b / 1024, sb = b % 1024, swz = sb ^ (((sb >> 9) & 1) << 5); R = (st >> 1) * 16 + swz / 64; C = (st & 1) * 32 + (swz % 64) / 2; }
__host__ __device__ __forceinline__ int perm32(int rho) { const int n = rho >> 4, i = rho & 15; return 8 * (i >> 2) + 4 * n + (i & 3); }

struct Unit { int pm, pn; };
struct Gemm { const bf16_t* A; const bf16_t* Bt; int M, N, K, lda, ldb; };

struct StaticOrder {
    int nM, nN, nwg, G, c;
    __host__ __device__ void init(int M, int N, int G_, int c_) { nM = M / BM; nN = N / BM; nwg = nM * nN; G = G_; c = c_; }
    __host__ __device__ bool next(int i, Unit& u) const {
        const long L = (long)i * G + c; if (L >= nwg) return false;
        int wgid = (int)L; { const int q = nwg / NXCD, r = nwg % NXCD, xcd = wgid % NXCD, off = wgid / NXCD; wgid = (xcd < r ? xcd * (q + 1) : r * (q + 1) + (xcd - r) * q) + off; }
        const int nig = WGM * nN, gid = wgid / nig, fm = gid * WGM, gsz = (nM - fm) < WGM ? (nM - fm) : WGM;
        u.pm = fm + ((wgid % nig) % gsz); u.pn = (wgid % nig) / gsz; return true;
    }
    __device__ __forceinline__ void a_ready(const Unit&) const {}
    __device__ __forceinline__ void done(const Unit&) const {}
};


__device__ __forceinline__ unsigned cvt_pk_bf16(float lo, float hi) { unsigned r; asm volatile("v_cvt_pk_bf16_f32 %0, %1, %2" : "=v"(r) : "v"(lo), "v"(hi)); return r; }
__device__ __forceinline__ float bflo(unsigned w) { return __builtin_bit_cast(float, w << 16); }
__device__ __forceinline__ float bfhi(unsigned w) { return __builtin_bit_cast(float, w & 0xffff0000u); }
constexpr int PROJ_LD = 5120;
constexpr float EPI_C2 = 0.125f * 1.4426950408889634f;
struct EpiProj {
    static constexpr bool PERM = true, AFTER_DRAIN = false;
    bf16_t* O;
    __device__ __forceinline__ void operator()(const f32x4 (&acc)[2][2][4][2], const Unit& u, int wr, int wc, int fr, int fq) const {
        const int row0 = u.pm * BM + wr * 64 + fr, col0 = u.pn * BM + wc * 32 + 8 * fq;
        const bool gate = u.pn >= 12; const float sc = (u.pn < 2 || (u.pn >= 6 && u.pn < 8)) ? EPI_C2 : 1.0f;
#pragma unroll
        for (int ai = 0; ai < 2; ++ai)
#pragma unroll
            for (int m = 0; m < 4; ++m) { bf16_t* rowp = O + (size_t)(row0 + ai * HALF + m * 16) * PROJ_LD + col0;
#pragma unroll
                for (int bj = 0; bj < 2; ++bj) { f32x4 v0 = acc[ai][bj][m][0], v1 = acc[ai][bj][m][1];
                    if (gate) {
#pragma unroll
                        for (int e = 0; e < 4; ++e) { v0[e] = __builtin_amdgcn_rcpf(1.0f + __expf(-v0[e])); v1[e] = __builtin_amdgcn_rcpf(1.0f + __expf(-v1[e])); }
                    } else { v0 = v0 * sc; v1 = v1 * sc; }
                    u32x4 w; w.x = cvt_pk_bf16(v0[0], v0[1]); w.y = cvt_pk_bf16(v0[2], v0[3]); w.z = cvt_pk_bf16(v1[0], v1[1]); w.w = cvt_pk_bf16(v1[2], v1[3]);
                    *(u32x4*)(rowp + bj * HALF) = w; } }
    }
};
struct EpiGate {
    static constexpr bool PERM = true, AFTER_DRAIN = false;
    bf16_t* P; int c_gate, c_add, c_out;
    __device__ __forceinline__ void operator()(const f32x4 (&acc)[2][2][4][2], const Unit& u, int wr, int wc, int fr, int fq) const {
        const int row0 = u.pm * BM + wr * 64 + fr, col0 = u.pn * BM + wc * 32 + 8 * fq;
#pragma unroll
        for (int ai = 0; ai < 2; ++ai)
#pragma unroll
            for (int m = 0; m < 4; ++m) { bf16_t* rowp = P + (size_t)(row0 + ai * HALF + m * 16) * PROJ_LD + col0;
#pragma unroll
                for (int bj = 0; bj < 2; ++bj) { const f32x4 v0 = acc[ai][bj][m][0], v1 = acc[ai][bj][m][1];
                    const u32x4 g = *(const u32x4*)(rowp + c_gate + bj * HALF);
                    float o[8] = {v0[0] * bflo(g.x), v0[1] * bfhi(g.x), v0[2] * bflo(g.y), v0[3] * bfhi(g.y), v1[0] * bflo(g.z), v1[1] * bfhi(g.z), v1[2] * bflo(g.w), v1[3] * bfhi(g.w)};
                    if (c_add >= 0) { const u32x4 a = *(const u32x4*)(rowp + c_add + bj * HALF);
                        o[0] += bflo(a.x); o[1] += bfhi(a.x); o[2] += bflo(a.y); o[3] += bfhi(a.y); o[4] += bflo(a.z); o[5] += bfhi(a.z); o[6] += bflo(a.w); o[7] += bfhi(a.w); }
                    u32x4 w; w.x = cvt_pk_bf16(o[0], o[1]); w.y = cvt_pk_bf16(o[2], o[3]); w.z = cvt_pk_bf16(o[4], o[5]); w.w = cvt_pk_bf16(o[6], o[7]);
                    *(u32x4*)(rowp + c_out + bj * HALF) = w; } }
    }
};
struct EpiResF32 {
    static constexpr bool PERM = false, AFTER_DRAIN = false;
    const float* base; float* out;
    __device__ __forceinline__ void operator()(const f32x4 (&acc)[2][2][4][2], const Unit& u, int wr, int wc, int fr, int fq) const {
        const int row0 = u.pm * BM + wr * 64 + fr, col0 = u.pn * BM + wc * 32 + 4 * fq;
#pragma unroll
        for (int ai = 0; ai < 2; ++ai)
#pragma unroll
            for (int m = 0; m < 4; ++m) { const size_t off = (size_t)(row0 + ai * HALF + m * 16) * 1024 + col0;
#pragma unroll
                for (int bj = 0; bj < 2; ++bj)
#pragma unroll
                    for (int n = 0; n < 2; ++n) { const f32x4 b = *(const f32x4*)(base + off + bj * HALF + n * 16); *(f32x4*)(out + off + bj * HALF + n * 16) = b + acc[ai][bj][m][n]; } }
    }
};
struct EpiRelu2 {
    static constexpr bool PERM = true, AFTER_DRAIN = false;
    bf16_t* O; int ldc;
    __device__ __forceinline__ void operator()(const f32x4 (&acc)[2][2][4][2], const Unit& u, int wr, int wc, int fr, int fq) const {
        const int row0 = u.pm * BM + wr * 64 + fr, col0 = u.pn * BM + wc * 32 + 8 * fq;
#pragma unroll
        for (int ai = 0; ai < 2; ++ai)
#pragma unroll
            for (int m = 0; m < 4; ++m) { bf16_t* rowp = O + (size_t)(row0 + ai * HALF + m * 16) * ldc + col0;
#pragma unroll
                for (int bj = 0; bj < 2; ++bj) { f32x4 v0 = acc[ai][bj][m][0], v1 = acc[ai][bj][m][1];
#pragma unroll
                    for (int e = 0; e < 4; ++e) { const float a = fmaxf(v0[e], 0.f), b = fmaxf(v1[e], 0.f); v0[e] = a * a; v1[e] = b * b; }
                    u32x4 w; w.x = cvt_pk_bf16(v0[0], v0[1]); w.y = cvt_pk_bf16(v0[2], v0[3]); w.z = cvt_pk_bf16(v1[0], v1[1]); w.w = cvt_pk_bf16(v1[2], v1[3]);
                    *(u32x4*)(rowp + bj * HALF) = w; } }
    }
};


struct EpiX1 {
    static constexpr bool PERM = false, AFTER_DRAIN = false;
    const float* base; float* out; bf16_t* xb; float* ss;
    __device__ __forceinline__ void operator()(const f32x4 (&acc)[2][2][4][2], const Unit& u, int wr, int wc, int fr, int fq) const {
        typedef unsigned u32x2 __attribute__((ext_vector_type(2)));
        const int row0 = u.pm * BM + wr * 64 + fr, col0 = u.pn * BM + wc * 32 + 4 * fq;
#pragma unroll
        for (int ai = 0; ai < 2; ++ai)
#pragma unroll
            for (int m = 0; m < 4; ++m) { const int row = row0 + ai * HALF + m * 16; const size_t off = (size_t)row * 1024 + col0; float s = 0.f;
#pragma unroll
                for (int bj = 0; bj < 2; ++bj)
#pragma unroll
                    for (int n = 0; n < 2; ++n) { const f32x4 b = *(const f32x4*)(base + off + bj * HALF + n * 16); const f32x4 v = b + acc[ai][bj][m][n];
                        *(f32x4*)(out + off + bj * HALF + n * 16) = v; s += (v[0] * v[0] + v[1] * v[1]) + (v[2] * v[2] + v[3] * v[3]);
                        u32x2 w; w.x = cvt_pk_bf16(v[0], v[1]); w.y = cvt_pk_bf16(v[2], v[3]); *(u32x2*)(xb + off + bj * HALF + n * 16) = w; }
                s += __shfl_xor(s, 16); s += __shfl_xor(s, 32);
                if (fq == 0) ss[(size_t)row * 16 + 4 * u.pn + wc] = s; }
    }
};
struct EpiRelu2N {
    static constexpr bool PERM = true, AFTER_DRAIN = false;
    bf16_t* O; int ldc; const float* ss;
    __device__ __forceinline__ void operator()(const f32x4 (&acc)[2][2][4][2], const Unit& u, int wr, int wc, int fr, int fq) const {
        const int row0 = u.pm * BM + wr * 64 + fr, col0 = u.pn * BM + wc * 32 + 8 * fq;
#pragma unroll
        for (int ai = 0; ai < 2; ++ai)
#pragma unroll
            for (int m = 0; m < 4; ++m) { const int row = row0 + ai * HALF + m * 16; bf16_t* rowp = O + (size_t)row * ldc + col0;
                const f32x4* sp = (const f32x4*)(ss + (size_t)row * 16); const f32x4 s0 = sp[0], s1 = sp[1], s2 = sp[2], s3 = sp[3];
                const float tot = ((s0[0] + s0[1]) + (s0[2] + s0[3])) + ((s1[0] + s1[1]) + (s1[2] + s1[3])) + ((s2[0] + s2[1]) + (s2[2] + s2[3])) + ((s3[0] + s3[1]) + (s3[2] + s3[3]));
                const float r = 1.0f / sqrtf(tot * (1.0f / 1024.0f) + 1e-6f);
#pragma unroll
                for (int bj = 0; bj < 2; ++bj) { f32x4 v0 = acc[ai][bj][m][0], v1 = acc[ai][bj][m][1];
#pragma unroll
                    for (int e = 0; e < 4; ++e) { const float a = fmaxf(v0[e] * r, 0.f), b = fmaxf(v1[e] * r, 0.f); v0[e] = a * a; v1[e] = b * b; }
                    u32x4 w; w.x = cvt_pk_bf16(v0[0], v0[1]); w.y = cvt_pk_bf16(v0[2], v0[3]); w.z = cvt_pk_bf16(v1[0], v1[1]); w.w = cvt_pk_bf16(v1[2], v1[3]);
                    *(u32x4*)(rowp + bj * HALF) = w; } }
    }
};
template <class Epi, class Sched, bool ALIGN_EPI = false, bool SP2 = false>
__device__ __forceinline__ void gemm_phase(PG8_LAS unsigned char* lds, const Gemm g, const Sched& S, const Epi& E) {
    int tid_ = threadIdx.x; asm volatile("" : "+v"(tid_));
    const int tid = tid_, wid = __builtin_amdgcn_readfirstlane(tid >> 6), lane = tid & 63, wr = wid >> 2, wc = wid & 3, fr = lane & 15, fq = lane >> 4;
    const int K = g.K, nt = K / BK;
    unsigned voffA[2], voffB[2];
#pragma unroll
    for (int i = 0; i < 2; ++i) { int R, C; stage_rc(tid * 16 + i * 8192, R, C); const int Rb = Epi::PERM ? ((R & ~31) + perm32(R & 31)) : R;
        voffA[i] = (unsigned)(R * g.lda + C) * 2u; voffB[i] = (unsigned)(Rb * g.ldb + C) * 2u; }
    const size_t kstep = (size_t)(BK * 2);
    const size_t hstepA = (size_t)HALF * g.lda * 2, hstepB = (size_t)HALF * g.ldb * 2;
    const size_t tstepA = 2 * hstepA, tstepB = 2 * hstepB;
    const unsigned ldsw = (unsigned)wid * 1024u;
    const int aoff = lds_byte(wr * 64 + fr, fq * 8), boff = lds_byte(wc * 32 + fr, fq * 8);
#define PG8_SA(b, h) (((b) * 2 + (h)) * HTB)
#define PG8_SB(b, h) ((4 + (b) * 2 + (h)) * HTB)
#define PG8_STAGE(bufoff, gbase, voff) do { _Pragma("unroll") for (int _i = 0; _i < 2; ++_i) \
        __builtin_amdgcn_global_load_lds((const unsigned*)((const char*)(gbase) + (voff)[_i]), (PG8_LAS unsigned*)(lds + (bufoff) + ldsw + _i * 8192), 16, 0, 0); } while (0)
#define PG8_LDA(dst, b, h) do { _Pragma("unroll") for (int m = 0; m < 4; ++m) _Pragma("unroll") for (int k = 0; k < 2; ++k) dst[m][k] = *(const PG8_LAS bf16x8*)(lds + PG8_SA(b, h) + aoff + m * 2048 + k * 1024); } while (0)
#define PG8_LDB(dst, b, h) do { _Pragma("unroll") for (int n = 0; n < 2; ++n) _Pragma("unroll") for (int k = 0; k < 2; ++k) dst[n][k] = *(const PG8_LAS bf16x8*)(lds + PG8_SB(b, h) + boff + n * 2048 + k * 1024); } while (0)
#define PG8_MMA(ai, bj, At, Bt) do { __builtin_amdgcn_s_setprio(1); _Pragma("unroll") for (int m = 0; m < 4; ++m) _Pragma("unroll") for (int n = 0; n < 2; ++n) _Pragma("unroll") for (int k = 0; k < 2; ++k) \
        acc[ai][bj][m][n] = __builtin_amdgcn_mfma_f32_16x16x32_bf16(Bt[n][k], At[m][k], acc[ai][bj][m][n], 0, 0, 0); __builtin_amdgcn_s_setprio(0); } while (0)
#define PG8_WAIT_V(n) asm volatile("s_waitcnt vmcnt(" #n ")" ::: "memory")
#define PG8_WAIT_L(n) asm volatile("s_waitcnt lgkmcnt(" #n ")" ::: "memory")
#define PG8_BAR __builtin_amdgcn_s_barrier()
#define PG8_SCHED __builtin_amdgcn_sched_barrier(0)
    Unit cur, nxt; int ui = 0;
    if (!S.next(0, cur)) return;
    f32x4 acc[2][2][4][2];
#pragma unroll
    for (int a = 0; a < 2; ++a)
#pragma unroll
        for (int b = 0; b < 2; ++b)
#pragma unroll
            for (int m = 0; m < 4; ++m)
#pragma unroll
                for (int n = 0; n < 2; ++n) acc[a][b][m][n] = (f32x4){0.f, 0.f, 0.f, 0.f};
    bf16x8 At[4][2], B0[2][2], B1[2][2];
    const char* cA = (const char*)g.A + (size_t)cur.pm * tstepA; const char* cB = (const char*)g.Bt + (size_t)cur.pn * tstepB;
    S.a_ready(cur);
    if constexpr (SP2) {
        PG8_STAGE(PG8_SB(0, 0), cB, voffB); PG8_STAGE(PG8_SB(0, 1), cB + hstepB, voffB); PG8_STAGE(PG8_SA(0, 0), cA, voffA); PG8_STAGE(PG8_SA(0, 1), cA + hstepA, voffA);
        if (wr == 1) PG8_BAR;
        PG8_WAIT_V(2); PG8_BAR;
        PG8_STAGE(PG8_SB(1, 0), cB + kstep, voffB); PG8_STAGE(PG8_SA(1, 0), cA + kstep, voffA); PG8_STAGE(PG8_SB(1, 1), cB + hstepB + kstep, voffB);
        PG8_WAIT_V(6); PG8_BAR;
    } else {
        PG8_STAGE(PG8_SB(0, 0), cB, voffB); PG8_STAGE(PG8_SA(0, 0), cA, voffA); PG8_STAGE(PG8_SB(0, 1), cB + hstepB, voffB); PG8_STAGE(PG8_SA(0, 1), cA + hstepA, voffA);
        if (wr == 1) PG8_BAR;
        PG8_WAIT_V(4); PG8_BAR;
        PG8_STAGE(PG8_SB(1, 0), cB + kstep, voffB); PG8_STAGE(PG8_SA(1, 0), cA + kstep, voffA); PG8_STAGE(PG8_SB(1, 1), cB + hstepB + kstep, voffB);
        PG8_WAIT_V(6); PG8_BAR;
    }
    for (;;) {
        const bool has_next = S.next(ui + 1, nxt);
        const char* nA = has_next ? (const char*)g.A + (size_t)nxt.pm * tstepA : cA; const char* nB = has_next ? (const char*)g.Bt + (size_t)nxt.pn * tstepB : cB;
        for (int t = 0; t < nt; t += 2) {
            const bool last = (t == nt - 2);
            const char* a1 = cA + (size_t)(t + 1) * kstep;
            const char* a2 = last ? nA : cA + (size_t)(t + 2) * kstep; const char* b2 = last ? nB : cB + (size_t)(t + 2) * kstep;
            const char* a3 = a2 + kstep; const char* b3 = b2 + kstep;
            if (last && has_next) S.a_ready(nxt);
            if constexpr (SP2) {
            PG8_LDB(B0, 0, 0); PG8_LDB(B1, 0, 1); PG8_SCHED; PG8_LDA(At, 0, 0); PG8_STAGE(PG8_SA(1, 1), a1 + hstepA, voffA);
            PG8_WAIT_V(8); PG8_WAIT_L(0); PG8_BAR; PG8_MMA(0, 0, At, B0); PG8_MMA(0, 1, At, B1); PG8_BAR; PG8_SCHED;
            PG8_LDA(At, 0, 1); PG8_STAGE(PG8_SB(0, 0), b2, voffB); PG8_STAGE(PG8_SB(0, 1), b2 + hstepB, voffB); PG8_STAGE(PG8_SA(0, 0), a2, voffA);
            PG8_WAIT_V(8); PG8_WAIT_L(0); PG8_BAR; PG8_MMA(1, 0, At, B0); PG8_MMA(1, 1, At, B1); PG8_BAR; PG8_SCHED;
            PG8_LDB(B0, 1, 0); PG8_LDB(B1, 1, 1); PG8_SCHED; PG8_LDA(At, 1, 0); PG8_STAGE(PG8_SA(0, 1), a2 + hstepA, voffA);
            PG8_WAIT_V(8); PG8_WAIT_L(0); PG8_BAR; PG8_MMA(0, 0, At, B0); PG8_MMA(0, 1, At, B1); PG8_BAR; PG8_SCHED;
            PG8_LDA(At, 1, 1); PG8_STAGE(PG8_SB(1, 0), b3, voffB); PG8_STAGE(PG8_SB(1, 1), b3 + hstepB, voffB); PG8_STAGE(PG8_SA(1, 0), a3, voffA);
            PG8_WAIT_V(8); PG8_WAIT_L(0); PG8_BAR; PG8_MMA(1, 0, At, B0); PG8_MMA(1, 1, At, B1); PG8_BAR; PG8_SCHED;
            } else {
            PG8_LDB(B0, 0, 0); PG8_SCHED; PG8_LDA(At, 0, 0); PG8_STAGE(PG8_SA(1, 1), a1 + hstepA, voffA);
            PG8_WAIT_L(8); PG8_BAR; PG8_WAIT_L(0); PG8_MMA(0, 0, At, B0); PG8_BAR; PG8_SCHED;
            PG8_LDB(B1, 0, 1); PG8_STAGE(PG8_SB(0, 0), b2, voffB);
            PG8_BAR; PG8_WAIT_L(0); PG8_MMA(0, 1, At, B1); PG8_BAR;
            PG8_LDA(At, 0, 1); PG8_STAGE(PG8_SA(0, 0), a2, voffA);
            PG8_BAR; PG8_WAIT_L(0); PG8_MMA(1, 0, At, B0); PG8_BAR; PG8_SCHED;
            PG8_STAGE(PG8_SB(0, 1), b2 + hstepB, voffB);
            PG8_WAIT_V(6); PG8_BAR; PG8_MMA(1, 1, At, B1); PG8_BAR;
            PG8_LDB(B0, 1, 0); PG8_SCHED; PG8_LDA(At, 1, 0); PG8_STAGE(PG8_SA(0, 1), a2 + hstepA, voffA);
            PG8_WAIT_L(8); PG8_BAR; PG8_WAIT_L(0); PG8_MMA(0, 0, At, B0); PG8_BAR; PG8_SCHED;
            PG8_LDB(B1, 1, 1); PG8_STAGE(PG8_SB(1, 0), b3, voffB);
            PG8_BAR; PG8_WAIT_L(0); PG8_MMA(0, 1, At, B1); PG8_BAR;
            PG8_LDA(At, 1, 1); PG8_STAGE(PG8_SA(1, 0), a3, voffA);
            PG8_BAR; PG8_WAIT_L(0); PG8_MMA(1, 0, At, B0); PG8_BAR; PG8_SCHED;
            PG8_STAGE(PG8_SB(1, 1), b3 + hstepB, voffB);
            PG8_WAIT_V(6); PG8_BAR; PG8_MMA(1, 1, At, B1); PG8_BAR;
            }
        }
        if constexpr (ALIGN_EPI) { if (wr == 0) PG8_BAR; }
        if constexpr (!Epi::AFTER_DRAIN) { E(acc, cur, wr, wc, fr, fq); S.done(cur); }
        if (!has_next) break;
#pragma unroll
        for (int a = 0; a < 2; ++a)
#pragma unroll
            for (int b = 0; b < 2; ++b)
#pragma unroll
                for (int m = 0; m < 4; ++m)
#pragma unroll
                    for (int n = 0; n < 2; ++n) acc[a][b][m][n] = (f32x4){0.f, 0.f, 0.f, 0.f};
        cur = nxt; cA = nA; cB = nB; ++ui;
        if constexpr (ALIGN_EPI) { if (wr == 1) PG8_BAR; }
    }
    PG8_WAIT_V(0);
    if constexpr (!ALIGN_EPI) { if (wr == 0) PG8_BAR; }
    PG8_BAR;
    if constexpr (Epi::AFTER_DRAIN) { E.fused(acc, cur, wr, wc, fr, fq, lds, wid, lane); S.done(cur); }
#undef PG8_SA
#undef PG8_SB
#undef PG8_STAGE
#undef PG8_LDA
#undef PG8_LDB
#undef PG8_MMA
#undef PG8_WAIT_V
#undef PG8_WAIT_L
#undef PG8_BAR
#undef PG8_SCHED
}
}
namespace attn_body {
using bf16=__hip_bfloat16;
using bf16x8=__attribute__((ext_vector_type(8)))short;
using s16x4=__attribute__((ext_vector_type(4)))short;
using f32x16=__attribute__((ext_vector_type(16)))float;
using u32x4=__attribute__((ext_vector_type(4)))unsigned;
using f32x4=__attribute__((ext_vector_type(4)))float;
constexpr int SEQ=2048,D=64,DM=5120;
constexpr int NW=8,QBLK=32,QB=QBLK*NW,KVBLK=64,NQB=SEQ/QB;
constexpr int ATTN_PITCH=DM, ATTN_UNIT_ROWS=QB;
__device__ __forceinline__ int crow(int r,int hi){return (r&3)+8*(r>>2)+4*hi;}
#define SBAR() __builtin_amdgcn_sched_barrier(0)
__device__ __forceinline__ void cmask(f32x16&p0,f32x16&p1,int jb,int qrel,int hi){
  const float NEG=-INFINITY; int kb=64*jb+4*hi;
  #pragma unroll
  for(int r=0;r<16;++r){int kv=kb+(r&3)+8*(r>>2); if(kv>qrel)p0[r]=NEG; if(kv+32>qrel)p1[r]=NEG;}
}

__device__ __forceinline__ void dmask(f32x16&p0,f32x16&p1,int jb,int wid){
  if(jb>(wid>>1)){
    #pragma unroll
    for(int r=0;r<16;++r){p0[r]=-INFINITY;p1[r]=-INFINITY;}
  }
}
template<int MODE> __device__ __forceinline__ f32x16 csel(const f32x16&c,const f32x16&n){ if constexpr(MODE==0) return c; else return n; }

constexpr int NSLOT=3, SLOTB=8192;
constexpr int LDS_K=0, LDS_V=NSLOT*SLOTB, LDS_WS=2*NSLOT*SLOTB, LDS_OST=LDS_WS+NW*64*4, LDS_TAB=LDS_OST+NW*4096, LDS_BYTES=LDS_TAB+8192;
constexpr float C2=0.125f*1.4426950408889634f;
__device__ __forceinline__ void glds16(const void*gsrc,unsigned lds_dst){unsigned keep;
  asm volatile("s_mov_b32 %0, m0\n\ts_mov_b32 m0, %2\n\ts_nop 0\n\tglobal_load_lds_dwordx4 %1, off\n\ts_mov_b32 m0, %0":"=&s"(keep):"v"(gsrc),"s"(lds_dst):"memory");}
__device__ __forceinline__ float max3f(float a,float b,float c){float r;asm("v_max3_f32 %0, %1, %2, %3":"=v"(r):"v"(a),"v"(b),"v"(c));return r;}
__device__ __forceinline__ float max2f(float a,float b){float r;asm("v_max_f32_e32 %0, %1, %2":"=v"(r):"v"(a),"v"(b));return r;}
__device__ __forceinline__ float fadd_s(float a,float b){float r;asm("v_add_f32_e32 %0, %1, %2":"=v"(r):"v"(a),"v"(b));return r;}
__device__ __forceinline__ float fsub_s(float a,float b){float r;asm("v_sub_f32_e32 %0, %1, %2":"=v"(r):"v"(a),"v"(b));return r;}
typedef float f32x2_t __attribute__((ext_vector_type(2))); typedef __bf16 bf16x2_t __attribute__((ext_vector_type(2)));
__device__ __forceinline__ unsigned cvtpk_s(float lo,float hi){f32x2_t v={lo,hi};bf16x2_t b=__builtin_convertvector(v,bf16x2_t);return __builtin_bit_cast(unsigned,b);}
#define WAIT_BAR(N) asm volatile("s_waitcnt vmcnt(" #N ") lgkmcnt(0)\n\ts_barrier":::"memory")

__device__ __forceinline__ void qkt(f32x16&p0,f32x16&p1,const char*Kslot,const bf16x8*qr,const f32x16&c0,const f32x16&c1,int r32,int hi){
  const char*kb=Kslot+hi*1024+r32*16;
  #pragma unroll
  for(int d0=0;d0<4;++d0){
    const bf16x8 b0=*reinterpret_cast<const bf16x8*>(kb+d0*2048);
    const bf16x8 b1=*reinterpret_cast<const bf16x8*>(kb+d0*2048+512);
    if(d0==0){p0=__builtin_amdgcn_mfma_f32_32x32x16_bf16(b0,qr[0],c0,0,0,0);p1=__builtin_amdgcn_mfma_f32_32x32x16_bf16(b1,qr[0],c1,0,0,0);}
    else{p0=__builtin_amdgcn_mfma_f32_32x32x16_bf16(b0,qr[d0],p0,0,0,0);p1=__builtin_amdgcn_mfma_f32_32x32x16_bf16(b1,qr[d0],p1,0,0,0);}}
}
typedef __attribute__((address_space(3))) const char* lds_cptr;
typedef short v4i16_t __attribute__((ext_vector_type(4)));
__device__ __forceinline__ void kload8(bf16x8*kf,lds_cptr kp){
  kf[0]=*(const __attribute__((address_space(3))) bf16x8*)(kp);      kf[1]=*(const __attribute__((address_space(3))) bf16x8*)(kp+512);
  kf[2]=*(const __attribute__((address_space(3))) bf16x8*)(kp+2048); kf[3]=*(const __attribute__((address_space(3))) bf16x8*)(kp+2560);
  kf[4]=*(const __attribute__((address_space(3))) bf16x8*)(kp+4096); kf[5]=*(const __attribute__((address_space(3))) bf16x8*)(kp+4608);
  kf[6]=*(const __attribute__((address_space(3))) bf16x8*)(kp+6144); kf[7]=*(const __attribute__((address_space(3))) bf16x8*)(kp+6656);
}
__device__ __forceinline__ void kload2(bf16x8*kf,lds_cptr kp,int j){ kf[2*j]=*(const __attribute__((address_space(3))) bf16x8*)(kp+j*2048); kf[2*j+1]=*(const __attribute__((address_space(3))) bf16x8*)(kp+j*2048+512); }
__device__ __forceinline__ s16x4 vtr(lds_cptr p){ return __builtin_bit_cast(s16x4,__builtin_amdgcn_ds_read_tr16_b64_v4i16((__attribute__((address_space(3))) v4i16_t*)p)); }
__device__ __forceinline__ float rowmax(const f32x16&p0,const f32x16&p1){
  float a=max3f(p0[0],p0[1],p1[0]),b=max3f(p0[2],p0[3],p1[1]);a=max3f(a,p1[2],p1[3]);
  #pragma unroll
  for(int r=4;r<16;r+=4){a=max3f(a,p0[r],p0[r+1]);b=max3f(b,p0[r+2],p0[r+3]);a=max3f(a,p1[r],p1[r+1]);b=max3f(b,p1[r+2],p1[r+3]);}
  const float m=max2f(a,b);
  auto rr=__builtin_amdgcn_permlane32_swap(__float_as_uint(m),__float_as_uint(m),false,false);
  return max2f(__uint_as_float(rr[0]),__uint_as_float(rr[1]));
}
__device__ __forceinline__ void pv(f32x16*o,int vb,bf16x8 pa0,bf16x8 pa1,bf16x8 pa2,bf16x8 pa3){
  #pragma unroll
  for(int d0=0;d0<2;++d0){s16x4 lo[4],hi[4];
    #pragma unroll
    for(int ks=0;ks<4;++ks){
      asm volatile("ds_read_b64_tr_b16 %0,%1 offset:%c2":"=&v"(lo[ks]):"v"(vb),"i"(d0*4096+ks*1024):"memory");
      asm volatile("ds_read_b64_tr_b16 %0,%1 offset:%c2":"=&v"(hi[ks]):"v"(vb),"i"(d0*4096+ks*1024+512):"memory");}
    asm volatile("s_waitcnt lgkmcnt(0)":::"memory");SBAR();
    #define PK(k) (bf16x8){lo[k][0],lo[k][1],lo[k][2],lo[k][3],hi[k][0],hi[k][1],hi[k][2],hi[k][3]}
    o[d0]=__builtin_amdgcn_mfma_f32_32x32x16_bf16(pa0,PK(0),o[d0],0,0,0);
    o[d0]=__builtin_amdgcn_mfma_f32_32x32x16_bf16(pa1,PK(1),o[d0],0,0,0);
    o[d0]=__builtin_amdgcn_mfma_f32_32x32x16_bf16(pa2,PK(2),o[d0],0,0,0);
    o[d0]=__builtin_amdgcn_mfma_f32_32x32x16_bf16(pa3,PK(3),o[d0],0,0,0);
    #undef PK
  }
}

#ifndef ATTN_STORE16
#define ATTN_STORE16(p,v) (*(u32x4*)(p)=(v))
#endif
template<int MODE,int THRL,int OP> __device__ __forceinline__ void attn_unit(int qb,const bf16*Qh,const bf16*__restrict__ Kh,const bf16*__restrict__ Vh,bf16*Oh,const float*__restrict__ tabsrc,char*shm){
  int tid_=threadIdx.x; asm volatile("":"+v"(tid_)); const int tid=tid_,lane=tid&63,r32=lane&31,hi=lane>>5; const int wid=__builtin_amdgcn_readfirstlane(tid>>6);
  const int q0=qb*QB;
  const bf16*Qw=Qh+(long)(q0+wid*QBLK)*DM;
  const unsigned lds0=(unsigned)(uintptr_t)shm;
  float*wsf=(float*)(shm+LDS_WS)+wid*64;
  const bf16*ksrc=Kh+(long)lane*DM+wid*8;
  const bf16*vsrc=Vh+(long)(16*(wid&3)+(lane>>2))*DM+(wid>>2)*32+(lane&3)*8;
  const unsigned kdst=lds0+LDS_K+wid*1024, vdst=lds0+LDS_V+wid*1024;
  #define DMA_K(t,slot) glds16(ksrc+(long)(t)*KVBLK*DM,(unsigned)__builtin_amdgcn_readfirstlane(kdst+(slot)))
  #define DMA_V(t,slot) glds16(vsrc+(long)(t)*KVBLK*DM,(unsigned)__builtin_amdgcn_readfirstlane(vdst+(slot)))
  const int vb0=(int)(lds0+LDS_V)+((lane>>4)&1)*32+(lane&3)*8+(4*hi+((lane&15)>>2))*64;
  const char*Kbase=shm+LDS_K; bf16x8 kf[8];
  const lds_cptr shm3=(lds_cptr)shm; const lds_cptr kp0=shm3+LDS_K+hi*1024+r32*16; const lds_cptr vp0=shm3+LDS_V+((lane>>4)&1)*32+(lane&3)*8+(4*hi+((lane&15)>>2))*64;
  const int qrel=wid*QBLK+r32;
  const int NT=(q0+QB)/KVBLK;
  float*tab=(float*)(shm+LDS_TAB);
  if(MODE==0){ if(tid<(q0+QB)/4){ const f32x4 v_=*(const f32x4*)(tabsrc+4*tid); ((f32x4*)tab)[tid]=-v_; } }
  else { if(tid<112){ f32x4 v_={0.f,0.f,0.f,0.f}; if(tid>=48)v_=*(const f32x4*)(tabsrc+4*(tid-48)); ((f32x4*)tab)[tid]=v_; } }
  #define CINIT(C0,C1,t) do{ if(MODE==0){ const float*tb_=tab+(t)*64+4*hi; \
      _Pragma("unroll") for(int g_=0;g_<4;++g_){ const f32x4 a_=*(const f32x4*)(tb_+8*g_), b_=*(const f32x4*)(tb_+32+8*g_); \
        _Pragma("unroll") for(int e_=0;e_<4;++e_){ C0[4*g_+e_]=a_[e_]; C1[4*g_+e_]=b_[e_]; } } \
      _Pragma("unroll") for(int r_=0;r_<16;++r_){ C0[r_]-=mhat; C1[r_]-=mhat; } } \
    else { const int jb_=(t)-(NT-4); \
      if(jb_>=-2){ const float*b_=tab+(64*jb_+4*hi-qrel+384); \
        _Pragma("unroll") for(int r_=0;r_<16;++r_){ C0[r_]=b_[(r_&3)+8*(r_>>2)]; C1[r_]=b_[(r_&3)+8*(r_>>2)+32]; } \
        _Pragma("unroll") for(int r_=0;r_<16;++r_){ C0[r_]-=mhat; C1[r_]-=mhat; } } \
      else { _Pragma("unroll") for(int r_=0;r_<16;++r_){ C0[r_]=-mhat; C1[r_]=-mhat; } } } }while(0)
  DMA_K(0,0);DMA_V(0,0);DMA_K(1,SLOTB);
  bf16x8 qr[4];
  #pragma unroll
  for(int d0=0;d0<4;++d0)qr[d0]=*reinterpret_cast<const bf16x8*>(&Qw[(long)r32*DM+d0*16+hi*8]);
  float mhat=0.f,l_reg=0.f;f32x16 o[2];o[0]=f32x16{};o[1]=f32x16{};
  #define CMASK(P0,P1,t) do{int jb_=(t)-(NT-4); if(MODE==0){ if(jb_>=0)cmask(P0,P1,jb_,qrel,hi); } else { if(jb_>=0)dmask(P0,P1,jb_,wid); } }while(0)
  bool resc=false;
  #define START(P0,P1) do{ const float rm=rowmax(P0,P1); resc=false; \
    { const float dl=rm; mhat=fadd_s(mhat,dl); \
      _Pragma("unroll") for(int r=0;r<16;++r){P0[r]=fsub_s(P0[r],dl);P1[r]=fsub_s(P1[r],dl);} \
       } \
    _Pragma("unroll") for(int r=0;r<16;++r)P0[r]=__builtin_amdgcn_exp2f(P0[r]); }while(0)
  #define RESC() do{ if(resc){ asm volatile("s_waitcnt lgkmcnt(0)":::"memory"); \
      _Pragma("unroll") for(int d_=0;d_<2;++d_) _Pragma("unroll") for(int r=0;r<16;++r)o[d_][r]*=wsf[crow(r,hi)]; } }while(0)
  f32x16 pA0,pA1,pB0,pB1;
  int sl_prev=0,sl_cur=0,sl_next=SLOTB;
  #define ROT() do{sl_prev=sl_cur;sl_cur=sl_next;sl_next=(sl_next==(NSLOT-1)*SLOTB)?0:sl_next+SLOTB;}while(0)
  DMA_K(2,2*SLOTB);
  WAIT_BAR(3);
  CINIT(pA0,pA1,0);
  qkt(pA0,pA1,Kbase,qr,pA0,pA1,r32,hi);asm volatile("s_nop 15\n\ts_nop 7":"+v"(pA0),"+v"(pA1));CMASK(pA0,pA1,0);
  START(pA0,pA1);
  _Pragma("unroll") for(int r=0;r<16;++r)pA1[r]=__builtin_amdgcn_exp2f(pA1[r]);
  WAIT_BAR(0);
  DMA_K(3,0);DMA_V(1,SLOTB);
  ROT();
  kload8(kf,kp0+sl_cur);
  WAIT_BAR(2);
  s16x4 vlo[8],vhi[8]; u32x4 pw0,pw1,pw2,pw3;
  #define PKW(P,B) cvtpk_s(P[B],P[B+1])
  #define PAF(k) __builtin_bit_cast(bf16x8,pw##k)
  #define VFR(i) (bf16x8){vlo[i][0],vlo[i][1],vlo[i][2],vlo[i][3],vhi[i][0],vhi[i][1],vhi[i][2],vhi[i][3]}
  #define PIN(x) asm volatile("":"+v"(x))
  #define MX3(a,b,c) __builtin_fmaxf(__builtin_fmaxf((a),(b)),(c))
  #define GAPA(MF,A0,A1,A2,A3,W0,W1,PW) do{ MF; sacc+=A0; sacc+=A1; sacc+=A2; sacc+=A3; PIN(sacc); W0; W1; PIN(PW); SBAR(); }while(0)
  #define EX(v) __builtin_amdgcn_exp2f(v)
  #define GAPB(MF,X,B) do{ MF; X[B]=EX(X[B]); X[B+1]=EX(X[B+1]); X[B+2]=EX(X[B+2]); X[B+3]=EX(X[B+3]); PIN(X); SBAR(); }while(0)
  #define VRD(i) do{ vlo[i]=vtr(vp_+(((i)>>2)*4096+((i)&3)*1024)); vhi[i]=vtr(vp_+(((i)>>2)*4096+((i)&3)*1024+512)); }while(0)
  #define KRD(G,j) do{ if(G){ kload2(kf,kp0+sl_next,j); SBAR(); } }while(0)
  #define STEP(C0,C1,P0,P1,t,GK,GV,GL) do{ CINIT(C0,C1,t); SBAR(); \
    const lds_cptr vp_=vp0+sl_prev; \
    VRD(0); SBAR(); float sacc=(P0[0]+P0[1]); \
    GAPA(C0=__builtin_amdgcn_mfma_f32_32x32x16_bf16(kf[0],qr[0],C0,0,0,0), P0[2],P0[3],P0[4],P0[5],     pw0[0]=PKW(P0,0), pw0[1]=PKW(P0,2), pw0); \
    VRD(4); SBAR(); GAPA(C1=__builtin_amdgcn_mfma_f32_32x32x16_bf16(kf[1],qr[0],C1,0,0,0), P0[6],P0[7],P0[8],P0[9],     pw0[2]=PKW(P0,4), pw0[3]=PKW(P0,6), pw0); \
    VRD(1); SBAR(); GAPA(C0=__builtin_amdgcn_mfma_f32_32x32x16_bf16(kf[2],qr[1],C0,0,0,0),   P0[10],P0[11],P0[12],P0[13], pw1[0]=PKW(P0,8), pw1[1]=PKW(P0,10), pw1); \
    VRD(5); SBAR(); GAPA(C1=__builtin_amdgcn_mfma_f32_32x32x16_bf16(kf[3],qr[1],C1,0,0,0),   P0[14],P0[15],P1[0],P1[1],   pw1[2]=PKW(P0,12),pw1[3]=PKW(P0,14), pw1); \
    VRD(2); SBAR(); GAPA(C0=__builtin_amdgcn_mfma_f32_32x32x16_bf16(kf[4],qr[2],C0,0,0,0),   P1[2],P1[3],P1[4],P1[5],     pw2[0]=PKW(P1,0), pw2[1]=PKW(P1,2), pw2); \
    VRD(6); SBAR(); GAPA(C1=__builtin_amdgcn_mfma_f32_32x32x16_bf16(kf[5],qr[2],C1,0,0,0),   P1[6],P1[7],P1[8],P1[9],     pw2[2]=PKW(P1,4), pw2[3]=PKW(P1,6), pw2); \
    VRD(3); SBAR(); GAPA(C0=__builtin_amdgcn_mfma_f32_32x32x16_bf16(kf[6],qr[3],C0,0,0,0),   P1[10],P1[11],P1[12],P1[13], pw3[0]=PKW(P1,8), pw3[1]=PKW(P1,10), pw3); \
    VRD(7); SBAR(); GAPA(C1=__builtin_amdgcn_mfma_f32_32x32x16_bf16(kf[7],qr[3],C1,0,0,0),   P1[14],P1[15],0.f,0.f,       pw3[2]=PKW(P1,12),pw3[3]=PKW(P1,14), pw3); \
    l_reg+=sacc; \
    if(GK){DMA_K((t)+3,sl_cur);} if(GV){DMA_V((t)+1,sl_next);} \
    CMASK(C0,C1,t); \
    { float a=MX3(C0[0],C0[1],C1[0]),b=MX3(C0[2],C0[3],C1[1]); a=MX3(a,C1[2],C1[3]); \
      _Pragma("unroll") for(int r=4;r<16;r+=4){a=MX3(a,C0[r],C0[r+1]);b=MX3(b,C0[r+2],C0[r+3]);a=MX3(a,C1[r],C1[r+1]);b=MX3(b,C1[r+2],C1[r+3]);} \
      float rm=__builtin_fmaxf(a,b); { auto rr=__builtin_amdgcn_permlane32_swap(__float_as_uint(rm),__float_as_uint(rm),false,false); rm=__builtin_fmaxf(__uint_as_float(rr[0]),__uint_as_float(rr[1])); } \
      resc=false; \
      if(__builtin_expect(__any(rm>(float)THRL),0)){ const float dl=__builtin_fmaxf(rm,0.f); mhat+=dl; \
        _Pragma("unroll") for(int r=0;r<16;++r){C0[r]-=dl;C1[r]-=dl;} \
         \
        const float f=__builtin_amdgcn_exp2f(-dl); l_reg*=f; if(hi==0)wsf[r32]=f; resc=true; } } \
    SBAR(); \
    GAPB(o[0]=__builtin_amdgcn_mfma_f32_32x32x16_bf16(PAF(0),VFR(0),o[0],0,0,0), C0,0); \
    GAPB(o[1]=__builtin_amdgcn_mfma_f32_32x32x16_bf16(PAF(0),VFR(4),o[1],0,0,0), C0,4); \
    KRD(GL,0); GAPB(o[0]=__builtin_amdgcn_mfma_f32_32x32x16_bf16(PAF(1),VFR(1),o[0],0,0,0), C0,8); \
    KRD(GL,1); GAPB(o[1]=__builtin_amdgcn_mfma_f32_32x32x16_bf16(PAF(1),VFR(5),o[1],0,0,0), C0,12); \
    KRD(GL,2); GAPB(o[0]=__builtin_amdgcn_mfma_f32_32x32x16_bf16(PAF(2),VFR(2),o[0],0,0,0), C1,0); \
    KRD(GL,3); GAPB(o[1]=__builtin_amdgcn_mfma_f32_32x32x16_bf16(PAF(2),VFR(6),o[1],0,0,0), C1,4); \
    GAPB(o[0]=__builtin_amdgcn_mfma_f32_32x32x16_bf16(PAF(3),VFR(3),o[0],0,0,0), C1,8); \
    GAPB(o[1]=__builtin_amdgcn_mfma_f32_32x32x16_bf16(PAF(3),VFR(7),o[1],0,0,0), C1,12); \
    }while(0)
  int t=1;
  #undef CMASK
  #define CMASK(P0,P1,t) do{}while(0)
  for(;t+7<NT;t+=2){
    STEP(pB0,pB1,pA0,pA1,t,true,true,true);     WAIT_BAR(2); RESC(); ROT();
    STEP(pA0,pA1,pB0,pB1,t+1,true,true,true);   WAIT_BAR(2); RESC(); ROT();
  }
  #undef CMASK
  #define CMASK(P0,P1,t) do{int jb_=(t)-(NT-4); if(MODE==0){ if(jb_>=0)cmask(P0,P1,jb_,qrel,hi); } else { if(jb_>=0)dmask(P0,P1,jb_,wid); } }while(0)
  #define ENDW(tt) do{ if((tt)+3<NT){WAIT_BAR(2);} else if((tt)+2<NT){WAIT_BAR(1);} else {WAIT_BAR(0);} }while(0)
  for(;t+1<NT;t+=2){
    STEP(pB0,pB1,pA0,pA1,t,(t+3<NT),(t+1<NT),(t+1<NT));       ENDW(t);   RESC(); ROT();
    STEP(pA0,pA1,pB0,pB1,t+1,(t+4<NT),(t+2<NT),(t+2<NT));     ENDW(t+1); RESC(); ROT();
  }
  STEP(pB0,pB1,pA0,pA1,NT-1,false,false,false); RESC();
  { float sacc=pB0[0]+pB0[1]; _Pragma("unroll") for(int r=2;r<16;++r)sacc+=pB0[r]; _Pragma("unroll") for(int r=0;r<16;++r)sacc+=pB1[r]; l_reg+=sacc;
    pw0=(u32x4){PKW(pB0,0),PKW(pB0,2),PKW(pB0,4),PKW(pB0,6)};pw1=(u32x4){PKW(pB0,8),PKW(pB0,10),PKW(pB0,12),PKW(pB0,14)};pw2=(u32x4){PKW(pB1,0),PKW(pB1,2),PKW(pB1,4),PKW(pB1,6)};pw3=(u32x4){PKW(pB1,8),PKW(pB1,10),PKW(pB1,12),PKW(pB1,14)};
    SBAR(); pv(o,vb0+sl_cur,PAF(0),PAF(1),PAF(2),PAF(3)); }
  #undef PKW
  #undef PAF
  #undef VFR
  #undef PIN
  #undef MX3
  #undef GAPA
  #undef GAPB
  #undef EX
  #undef VRD
  #undef KRD
  #undef STEP
  #undef ENDW
  {auto rr=__builtin_amdgcn_permlane32_swap(__float_as_uint(l_reg),__float_as_uint(l_reg),false,false);l_reg=__uint_as_float(rr[0])+__uint_as_float(rr[1]);}
  if(hi==0)wsf[32+r32]=l_reg;asm volatile("s_waitcnt lgkmcnt(0)":::"memory");
  float rli[16];
  #pragma unroll
  for(int r=0;r<16;++r)rli[r]=__builtin_amdgcn_rcpf(wsf[32+crow(r,hi)]);
  bf16*Ow=Oh+(long)(q0+wid*QBLK)*OP;
  { bf16*stg=(bf16*)(shm+LDS_OST)+wid*2048;
    #pragma unroll
    for(int r=0;r<16;++r){const int orow=crow(r,hi);
      #pragma unroll
      for(int d0=0;d0<2;++d0)stg[orow*64+d0*32+r32]=__float2bfloat16(o[d0][r]*rli[r]);}
    asm volatile("s_waitcnt lgkmcnt(0)":::"memory");
    #pragma unroll
    for(int i=0;i<4;++i){const int row=i*8+(lane>>3),ch=lane&7; const u32x4 v=*(const u32x4*)(stg+row*64+ch*8); ATTN_STORE16(Ow+(long)row*OP+ch*8,v);} }
  asm volatile("s_waitcnt lgkmcnt(0)\n\ts_barrier":::"memory");
  #undef DMA_K
  #undef DMA_V
  #undef CINIT
  #undef CMASK
  #undef START
  #undef RESC
  #undef ROT
}
constexpr int ATTN_LDS_BYTES=LDS_BYTES;
#undef SBAR
#undef WAIT_BAR
}
#ifndef PG8_SP2
#define PG8_SP2 true
#endif
#ifndef PG8_ALIGN
#define PG8_ALIGN true
#endif

typedef unsigned short bf16_t;
typedef short bf16x8 __attribute__((ext_vector_type(8)));
typedef float f32x4 __attribute__((ext_vector_type(4)));
typedef float f32x16 __attribute__((ext_vector_type(16)));
#define LAS __attribute__((address_space(3)))

constexpr int BATCH = 16, SEQ = 2048, DM = 1024, M = BATCH * SEQ, INC = 5128, NP = 5120, FF = 4096;
constexpr float EPS = 1e-6f, LOG2E = 1.4426950408889634f, C2 = 0.125f * LOG2E;
constexpr int C_DQ = 0, C_DK = 512, C_DV = 1024, C_FQ = 1536, C_FK = 2048, C_FV = 2560, C_G0 = 3072, C_G1 = 4096;
constexpr int C_OD = 0, C_MRG = 512, C_OF = 1536, C_T1 = 2048;

constexpr size_t MiB = 1u << 20;
constexpr size_t WS_WIN = 0, WS_WPA = 10 * MiB, WS_WPB = 11 * MiB, WS_WO = 12 * MiB, WS_W1 = 14 * MiB, WS_W2 = 22 * MiB;
constexpr size_t WS_LOGF = 30 * MiB, WS_FC = 31 * MiB, WS_BT = 32 * MiB, WS_CTL = 33 * MiB, WS_XN = 34 * MiB, WS_PROJ = 98 * MiB, WS_SS1 = 418 * MiB, WS_END = 420 * MiB;
constexpr size_t CTL_ZERO_BYTES = 64 * 1024;
constexpr int MISC_OFF = 131072 + 320;
constexpr int NWAVES = 8, NTHREADS = 512;
constexpr int LDS_BYTES = 147456;

struct Params {
    const float* x; const float* g_mix; const float* w_in; const float* b_f; const float* lq1; const float* lk1; const float* lq2; const float* lk2;
    const float* g_subln; const float* w_pa; const float* w_pb; const float* w_o; const float* g_mlp; const float* w_1; const float* w_2; const float* rel_table; const float* g_final;
    float* out; unsigned char* ws;
};

__device__ __forceinline__ unsigned f2bf(float f) { unsigned u = __builtin_bit_cast(unsigned, f); return (u + 0x7fffu + ((u >> 16) & 1u)) >> 16; }
__device__ __forceinline__ unsigned pk2(float lo, float hi) { return f2bf(lo) | (f2bf(hi) << 16); }
__device__ __forceinline__ float bf2f(bf16_t b) { return __builtin_bit_cast(float, (unsigned)b << 16); }
__device__ __forceinline__ float wave_sum(float v) {
#pragma unroll
    for (int o = 1; o < 64; o <<= 1) v += __shfl_xor(v, o);
    return v;
}
__device__ __forceinline__ int crow(int r, int hi) { return (r & 3) + 8 * (r >> 2) + 4 * hi; }

__device__ __forceinline__ void transpose_item(const float* W, int ldw, int K, bf16_t* WT, LAS float* scr, int kb, int nb, int lane, const float* gk = nullptr) {
    const int k0 = 64 * kb, n0 = 32 * nb;
#pragma unroll 8
    for (int i = 0; i < 32; ++i) { const int kk = 2 * i + (lane >> 5); float w_ = W[(size_t)(k0 + kk) * ldw + n0 + (lane & 31)]; if (gk) w_ *= gk[k0 + kk]; scr[kk * 33 + (lane & 31)] = w_; }
    asm volatile("s_waitcnt lgkmcnt(0)" ::: "memory");
    const int c = lane & 7;
#pragma unroll
    for (int j = 0; j < 4; ++j) { const int n = (lane >> 3) + 8 * j; const LAS float* s = scr + (8 * c) * 33 + n;
        uint4 o; o.x = pk2(s[0 * 33], s[1 * 33]); o.y = pk2(s[2 * 33], s[3 * 33]); o.z = pk2(s[4 * 33], s[5 * 33]); o.w = pk2(s[6 * 33], s[7 * 33]);
        *(uint4*)(WT + (size_t)(n0 + n) * K + k0 + 8 * c) = o; }
    asm volatile("s_waitcnt lgkmcnt(0)" ::: "memory");
}

__device__ __forceinline__ int rel_bucket(int rel) {
    const int ret = rel > 0 ? 16 : 0; const int n = rel < 0 ? -rel : rel;
    int v;
    if (n < 8) v = n; else { int lg = (31 - __clz(n * n)) - 6; v = 8 + lg; if (v > 15) v = 15; }
    return ret + v;
}

__device__ __forceinline__ void norm_row(const float* xrow, const float* g, bf16_t* orow, const LAS float* wfl  , const float* b_f, float* logf_row, int lane) {
    f32x4 v[4]; float s = 0.f;
#pragma unroll
    for (int j = 0; j < 4; ++j) { v[j] = *(const f32x4*)(xrow + 4 * lane + 256 * j); s += (v[j].x * v[j].x + v[j].y * v[j].y) + (v[j].z * v[j].z + v[j].w * v[j].w); }
    const float r = 1.0f / sqrtf(wave_sum(s) * (1.f / DM) + EPS);
    float fl[8];
#pragma unroll
    for (int h = 0; h < 8; ++h) fl[h] = 0.f;
#pragma unroll
    for (int j = 0; j < 4; ++j) {
        const f32x4 gg = *(const f32x4*)(g + 4 * lane + 256 * j);
        f32x4 y; y.x = v[j].x * r * gg.x; y.y = v[j].y * r * gg.y; y.z = v[j].z * r * gg.z; y.w = v[j].w * r * gg.w;
        uint2 o; o.x = pk2(y.x, y.y); o.y = pk2(y.z, y.w);
        *(uint2*)(orow + 4 * lane + 256 * j) = o;
        if (wfl) {
#pragma unroll
            for (int e = 0; e < 4; ++e) { const float yy = y[e];
                const LAS f32x4* wp = (const LAS f32x4*)(wfl + ((j * 4 + e) * 64 + lane) * 8); const f32x4 w0 = wp[0], w1 = wp[1];
                fl[0] += yy * w0.x; fl[1] += yy * w0.y; fl[2] += yy * w0.z; fl[3] += yy * w0.w; fl[4] += yy * w1.x; fl[5] += yy * w1.y; fl[6] += yy * w1.z; fl[7] += yy * w1.w; }
        }
    }
    if (wfl) {
#pragma unroll
        for (int h = 0; h < 8; ++h) fl[h] = wave_sum(fl[h]);
        if (lane < 8) { float z = 0.f;
#pragma unroll
            for (int h = 0; h < 8; ++h) if (lane == h) z = fl[h];
            z += b_f[lane];
            const float ls = fminf(z, 0.f) - log1pf(expf(-fabsf(z)));
            logf_row[lane] = ls; }
    }
}

__device__ __forceinline__ void phase_prologue(const Params& P, LAS unsigned char* lds, int bid, int nblk) {
    int tid_ = threadIdx.x; asm volatile("" : "+v"(tid_)); const int tid = tid_, lane = tid & 63, wave = tid >> 6, nw = NWAVES;
    const int gw = bid * nw + wave, NGW = nblk * nw;
    LAS float* scr = (LAS float*)lds + wave * (64 * 33);
    unsigned char* ws = P.ws;
    constexpr int I_INA = 16 * 96, I_INB = 16 * 64, I_PA = 8 * 32, I_PB = 8 * 32, I_O = 16 * 32, I_1 = 16 * 128, I_2 = 64 * 32;
    constexpr int NITEMS = I_INA + I_INB + I_PA + I_PB + I_O + I_1 + I_2;
    for (int it = gw; it < NITEMS; it += NGW) {
        int r = it;
        if (r < I_INA) { transpose_item(P.w_in, INC, 1024, (bf16_t*)(ws + WS_WIN), scr, r / 96, r % 96, lane); continue; } r -= I_INA;
        if (r < I_INB) { transpose_item(P.w_in + 3080, INC, 1024, (bf16_t*)(ws + WS_WIN) + (size_t)3072 * 1024, scr, r / 64, r % 64, lane); continue; } r -= I_INB;
        if (r < I_PA) { transpose_item(P.w_pa, 1024, 512, (bf16_t*)(ws + WS_WPA), scr, r / 32, r % 32, lane); continue; } r -= I_PA;
        if (r < I_PB) { transpose_item(P.w_pb, 1024, 512, (bf16_t*)(ws + WS_WPB), scr, r / 32, r % 32, lane); continue; } r -= I_PB;
        if (r < I_O) { transpose_item(P.w_o, 1024, 1024, (bf16_t*)(ws + WS_WO), scr, r / 32, r % 32, lane); continue; } r -= I_O;
        if (r < I_1) { transpose_item(P.w_1, 4096, 1024, (bf16_t*)(ws + WS_W1), scr, r / 128, r % 128, lane, P.g_mlp); continue; } r -= I_1;
        transpose_item(P.w_2, 1024, 4096, (bf16_t*)(ws + WS_W2), scr, r / 32, r % 32, lane);
    }
    if (bid == 0) {
        float* BT = (float*)(ws + WS_BT);
        for (int i = tid; i < 4 * 256; i += NTHREADS) { const int h = i >> 8, rel = (i & 255) - 192;
            BT[i] = (P.rel_table[rel_bucket(rel) * 4 + h] - P.rel_table[15 * 4 + h]) * LOG2E; }
    }
    LAS float* wl = (LAS float*)(lds + 73728);
    for (int k = tid; k < 1024; k += NTHREADS) { const f32x4 a = *(const f32x4*)(P.w_in + (size_t)k * INC + 3072), b = *(const f32x4*)(P.w_in + (size_t)k * INC + 3076);
        LAS f32x4* d = (LAS f32x4*)(wl + (((k >> 8) * 4 + (k & 3)) * 64 + ((k & 255) >> 2)) * 8); d[0] = a; d[1] = b; }
    __syncthreads();
    for (int m = gw; m < M; m += NGW)
        norm_row(P.x + (size_t)m * DM, P.g_mix, (bf16_t*)(ws + WS_XN) + (size_t)m * DM, wl, P.b_f, (float*)(ws + WS_LOGF) + (size_t)m * 8, lane);
    __syncthreads();
}

__device__ __forceinline__ void phase_cumsum(const Params& P, int bid, int nblk) {
    int tid_ = threadIdx.x; asm volatile("" : "+v"(tid_)); const int tid = tid_, lane = tid & 63, wave = tid >> 6, nw = NWAVES;
    const int gw = bid * nw + wave, NGW = nblk * nw;
    const float* LF = (const float*)(P.ws + WS_LOGF); float* FC = (float*)(P.ws + WS_FC);
    for (int seq = gw; seq < BATCH * 8; seq += NGW) {
        const int b = seq >> 3, h = seq & 7;
        const size_t base = ((size_t)b * SEQ + lane * 32) * 8 + h;
        float loc[32]; float run = 0.f;
#pragma unroll
        for (int i = 0; i < 32; ++i) { run += LF[base + (size_t)i * 8]; loc[i] = run; }
        float incl = run;
#pragma unroll
        for (int o = 1; o < 64; o <<= 1) { const float t = __shfl_up(incl, o); if (lane >= o) incl += t; }
        const float excl = incl - run;
#pragma unroll
        for (int i = 0; i < 32; ++i) FC[(size_t)seq * SEQ + lane * 32 + i] = (loc[i] + excl) * LOG2E;
    }
}

__device__ __forceinline__ void phase_attention(const Params& P, char* lds, int bid, int G, bool with_fox) {
    const int vcu = (G % 8 == 0) ? (bid % 8) * (G / 8) + bid / 8 : bid;
    const attn_body::bf16* PROJ = (const attn_body::bf16*)(P.ws + WS_PROJ); attn_body::bf16* ODRAW = (attn_body::bf16*)(P.ws + WS_XN);
    const float* FC = (const float*)(P.ws + WS_FC); const float* BT = (const float*)(P.ws + WS_BT);
    for (int c = vcu; c < 256; c += G) {
        const int b = c >> 4, k = c & 15; const size_t rb = (size_t)b * SEQ; const attn_body::bf16* base = PROJ + rb * NP;
        if (with_fox) { const int h = k >> 1;
          for (int i = 0; i < 4; ++i) { const int s = 2 * (k & 1) + (i >> 1), qb = (i & 1) ? s : 7 - s;
              attn_body::attn_unit<0, 64, NP>(qb, base + C_FQ + h * 64, base + C_FK + h * 64, base + C_FV + h * 64, (attn_body::bf16*)base + C_OF + h * 64, FC + (size_t)(b * 8 + h) * SEQ, lds); } }
        { const int hd = k >> 2, mp = (k >> 1) & 1, vhf = k & 1;
          for (int qb = 7; qb >= 0; --qb)
              attn_body::attn_unit<1, 8, 1024>(qb, base + C_DQ + hd * 128 + mp * 64, base + C_DK + hd * 128 + mp * 64, base + C_DV + hd * 128 + vhf * 64, ODRAW + rb * 1024 + hd * 256 + mp * 128 + vhf * 64, BT + hd * 256, lds); }
    }
}

__device__ __forceinline__ void phase_combine(const Params& P, int bid, int nblk) {
    int tid_ = threadIdx.x; asm volatile("" : "+v"(tid_)); const int tid = tid_, lane = tid & 63, wave = tid >> 6, nw = NWAVES;
    const int gw = bid * nw + wave, NGW = nblk * nw;
    const float s1 = wave_sum(P.lq1[lane] * P.lk1[lane]), s2 = wave_sum(P.lq2[lane] * P.lk2[lane]);
    const float lam = expf(s1) - expf(s2) + 0.2f;
    bf16_t* PROJ = (bf16_t*)(P.ws + WS_PROJ); const bf16_t* ODRAW = (const bf16_t*)(P.ws + WS_XN);
    const int h = lane >> 4, e0 = (lane & 15) * 8;
    float g[8];
#pragma unroll
    for (int j = 0; j < 8; ++j) g[j] = P.g_subln[e0 + j] * 0.8f;
    for (int m = gw; m < M; m += NGW) {
        const bf16x8 a = *(const bf16x8*)(ODRAW + (size_t)m * 1024 + h * 256 + e0), b = *(const bf16x8*)(ODRAW + (size_t)m * 1024 + h * 256 + 128 + e0);
        float v[8]; float ss = 0.f;
#pragma unroll
        for (int j = 0; j < 8; ++j) { v[j] = bf2f((bf16_t)a[j]) - lam * bf2f((bf16_t)b[j]); ss += v[j] * v[j]; }
        ss += __shfl_xor(ss, 1); ss += __shfl_xor(ss, 2); ss += __shfl_xor(ss, 4); ss += __shfl_xor(ss, 8);
        const float r = 1.0f / sqrtf(ss * (1.f / 128.f) + EPS);
        uint4 o; o.x = pk2(v[0] * r * g[0], v[1] * r * g[1]); o.y = pk2(v[2] * r * g[2], v[3] * r * g[3]); o.z = pk2(v[4] * r * g[4], v[5] * r * g[5]); o.w = pk2(v[6] * r * g[6], v[7] * r * g[7]);
        *(uint4*)(PROJ + (size_t)m * NP + C_OD + h * 128 + e0) = o;
    }
}

__device__ __forceinline__ void phase_final(const Params& P, int bid, int nblk) {
    int tid_ = threadIdx.x; asm volatile("" : "+v"(tid_)); const int tid = tid_, lane = tid & 63, wave = tid >> 6, nw = NWAVES;
    const int gw = bid * nw + wave, NGW = nblk * nw;
    for (int m = gw; m < M; m += NGW) {
        float* row = P.out + (size_t)m * DM; f32x4 v[4]; float s = 0.f;
#pragma unroll
        for (int j = 0; j < 4; ++j) { v[j] = *(const f32x4*)(row + 4 * lane + 256 * j); s += (v[j].x * v[j].x + v[j].y * v[j].y) + (v[j].z * v[j].z + v[j].w * v[j].w); }
        const float r = 1.0f / sqrtf(wave_sum(s) * (1.f / DM) + EPS);
#pragma unroll
        for (int j = 0; j < 4; ++j) { const f32x4 gg = *(const f32x4*)(P.g_final + 4 * lane + 256 * j); f32x4 y; y.x = v[j].x * r * gg.x; y.y = v[j].y * r * gg.y; y.z = v[j].z * r * gg.z; y.w = v[j].w * r * gg.w;
            *(f32x4*)(row + 4 * lane + 256 * j) = y; }
    }
}

#define XB_TMO      128
#define XB_XCNT(j)  (256  + 64 * (j))
#define XB_XSUB(j)  (1280 + 64 * (j))
#define XB_XGEN(j)  (2304 + 64 * (j))
#define XB_TOP      3328
#define XB_TOPGEN   3392
#define XCD_BAR_WORDS 3456
#define XB_SPIN_CAP (1u << 18)

__device__ __forceinline__ unsigned xb_ld(unsigned* p)              { return __hip_atomic_load(p, __ATOMIC_RELAXED, __HIP_MEMORY_SCOPE_AGENT); }
__device__ __forceinline__ unsigned xb_add(unsigned* p, unsigned v) { return __hip_atomic_fetch_add(p, v, __ATOMIC_RELAXED, __HIP_MEMORY_SCOPE_AGENT); }
__device__ __forceinline__ unsigned xb_xcc_id() { return (unsigned)__builtin_amdgcn_s_getreg((3 << 11) | 20) & 0xFu; }
#define XB_SPIN(cond, bar) do { unsigned _sp = 0; while (cond) { __builtin_amdgcn_s_sleep(1); \
    if ((++_sp & 255u) == 0u) { if (xb_ld(&(bar)[XB_TMO])) break; if (_sp > XB_SPIN_CAP) { atomicAdd(&(bar)[XB_TMO], 1u); break; } } } } while (0)

struct XcdBarrier {
    unsigned* bar; unsigned x;
    volatile LAS unsigned* st;
};

__device__ __forceinline__ XcdBarrier xcd_barrier_post(unsigned* bar, volatile LAS unsigned* st) {
    XcdBarrier b; b.bar = bar; b.x = xb_xcc_id(); b.st = st;
    if (threadIdx.x == 0) (void)xb_add(&bar[XB_XCNT(b.x)], 1u);
    return b;
}
__device__ __forceinline__ void xcd_barrier_complete(unsigned* bar, unsigned x, unsigned& nloc, unsigned& nx) {
    const unsigned G = gridDim.x * gridDim.y * gridDim.z;
    unsigned sum, cnt, mine, sp = 0u;
    for (;;) {
        sum = 0u; cnt = 0u; mine = 0u;
#pragma unroll
        for (unsigned j = 0; j < 16; ++j) { const unsigned c = xb_ld(&bar[XB_XCNT(j)]); sum += c; cnt += (c > 0u) ? 1u : 0u; mine = (j == x) ? c : mine; }
        if (sum == G) break;
        __builtin_amdgcn_s_sleep(1);
        if ((++sp & 255u) == 0u) { if (xb_ld(&bar[XB_TMO])) break; if (sp > XB_SPIN_CAP) { atomicAdd(&bar[XB_TMO], 1u); break; } }
    }
    nloc = mine > 0u ? mine : 1u; nx = cnt > 0u ? cnt : 1u;
}

__device__ __forceinline__ void xcd_barrier(const XcdBarrier& b) {
    asm volatile("s_waitcnt vmcnt(0)" ::: "memory");
    __syncthreads();
    if (threadIdx.x == 0) {
        unsigned* bar = b.bar;
        __builtin_amdgcn_s_waitcnt(0);
        unsigned nloc = b.st[0], nx = b.st[1];
        if (nloc == 0u) { xcd_barrier_complete(bar, b.x, nloc, nx); b.st[0] = nloc; b.st[1] = nx; }
        const unsigned old = xb_add(&bar[XB_XSUB(b.x)], 1u);
        const unsigned gen = old / nloc;
        if (old + 1u == (gen + 1u) * nloc) {
            __builtin_amdgcn_fence(__ATOMIC_RELEASE, "agent");
            asm volatile("s_waitcnt vmcnt(0)" ::: "memory");
            const unsigned og = xb_add(&bar[XB_TOP], 1u);
            const unsigned tg = og / nx;
            if (og + 1u == (tg + 1u) * nx) xb_add(&bar[XB_TOPGEN], 1u);
            else XB_SPIN(xb_ld(&bar[XB_TOPGEN]) == tg, bar);
            __builtin_amdgcn_fence(__ATOMIC_ACQUIRE, "agent");
            xb_add(&bar[XB_XGEN(b.x)], 1u);
            asm volatile("s_waitcnt vmcnt(0)" ::: "memory");
        } else {
            XB_SPIN(xb_ld(&bar[XB_XGEN(b.x)]) == gen, bar);
            __builtin_amdgcn_fence(__ATOMIC_ACQUIRE, "agent");
            asm volatile("s_waitcnt vmcnt(0)" ::: "memory");
        }
    }
    __syncthreads();
}

__global__ void __launch_bounds__(NTHREADS, 2) fwd_mega(Params P) {
    extern __shared__ __attribute__((aligned(16))) unsigned char lds_raw[];
    LAS unsigned char* lds = (LAS unsigned char*)lds_raw;
    const int bid = blockIdx.x, G = gridDim.x;
    bf16_t* PROJ = (bf16_t*)(P.ws + WS_PROJ); bf16_t* XN = (bf16_t*)(P.ws + WS_XN); float* SS1 = (float*)(P.ws + WS_SS1);
    volatile LAS unsigned* MISC = (volatile LAS unsigned*)(lds + MISC_OFF);
    for (int u = threadIdx.x; u < (LDS_BYTES - 131072) / 4; u += NTHREADS) ((LAS unsigned*)(lds + 131072))[u] = 0u;
    __syncthreads();
    cg::grid_group grid = cg::this_grid();
    if (bid == 0) { unsigned* bw = (unsigned*)(P.ws + WS_CTL); for (int u = threadIdx.x; u < XCD_BAR_WORDS; u += NTHREADS) __hip_atomic_store(bw + u, 0u, __ATOMIC_RELAXED, __HIP_MEMORY_SCOPE_AGENT); }
#ifndef PROBE
#define PROBE -1
#endif
#define PH0() phase_prologue(P, lds, bid, G)
#define PH1() do { pg8::Gemm g{XN, (const bf16_t*)(P.ws + WS_WIN), M, NP, 1024, 1024, 1024}; pg8::StaticOrder S; S.init(M, NP, G, bid); \
      pg8::EpiProj E{PROJ}; pg8::gemm_phase<pg8::EpiProj, pg8::StaticOrder, PG8_ALIGN, PG8_SP2>(lds, g, S, E); } while (0)
#define PH4() do { { pg8::Gemm g{PROJ + C_OD, (const bf16_t*)(P.ws + WS_WPA), M, 1024, 512, NP, 512}; pg8::StaticOrder S; S.init(M, 1024, G, bid); \
      pg8::EpiGate E{PROJ, C_G0, -1, C_T1}; pg8::gemm_phase<pg8::EpiGate, pg8::StaticOrder, PG8_ALIGN, PG8_SP2>(lds, g, S, E); } \
    { pg8::Gemm g{PROJ + C_OF, (const bf16_t*)(P.ws + WS_WPB), M, 1024, 512, NP, 512}; pg8::StaticOrder S; S.init(M, 1024, G, bid); \
      pg8::EpiGate E{PROJ, C_G1, C_T1, C_MRG}; pg8::gemm_phase<pg8::EpiGate, pg8::StaticOrder, PG8_ALIGN, PG8_SP2>(lds, g, S, E); } } while (0)
#define PH6() do { pg8::Gemm g{PROJ + C_MRG, (const bf16_t*)(P.ws + WS_WO), M, 1024, 1024, NP, 1024}; pg8::StaticOrder S; S.init(M, 1024, G, bid); \
      pg8::EpiX1 E{P.x, P.out, XN, SS1}; pg8::gemm_phase<pg8::EpiX1, pg8::StaticOrder, PG8_ALIGN, PG8_SP2>(lds, g, S, E); } while (0)
#define PH8() do { pg8::Gemm g{XN, (const bf16_t*)(P.ws + WS_W1), M, FF, 1024, 1024, 1024}; pg8::StaticOrder S; S.init(M, FF, G, bid); \
      pg8::EpiRelu2N E{PROJ, FF, SS1}; pg8::gemm_phase<pg8::EpiRelu2N, pg8::StaticOrder, PG8_ALIGN, PG8_SP2>(lds, g, S, E); } while (0)
#define PH9() do { pg8::Gemm g{PROJ, (const bf16_t*)(P.ws + WS_W2), M, 1024, FF, FF, FF}; pg8::StaticOrder S; S.init(M, 1024, G, bid); \
      pg8::EpiResF32 E{P.out, P.out}; pg8::gemm_phase<pg8::EpiResF32, pg8::StaticOrder, PG8_ALIGN, PG8_SP2>(lds, g, S, E); } while (0)
#define PH9DUMMY() do { pg8::Gemm g{PROJ, (const bf16_t*)(P.ws + WS_W2), M, 1024, FF, FF, FF}; pg8::StaticOrder S; S.init(M, 1024, G, bid); \
      pg8::EpiRelu2 E{XN, 1024}; pg8::gemm_phase<pg8::EpiRelu2, pg8::StaticOrder, PG8_ALIGN, PG8_SP2>(lds, g, S, E); } while (0)
    if (PROBE == 0) PH0();
    PH0();
    grid.sync();
    XcdBarrier bar = xcd_barrier_post((unsigned*)(P.ws + WS_CTL), MISC + 8);
#define GRID_BAR() xcd_barrier(bar)
    phase_cumsum(P, bid, G);
    if (PROBE == 1) { PH1(); GRID_BAR(); }
    PH1();
    GRID_BAR();
    if (PROBE == 2) { phase_attention(P, (char*)lds_raw, bid, G, false); GRID_BAR(); }
    phase_attention(P, (char*)lds_raw, bid, G, true);
    GRID_BAR();
    if (PROBE == 3) { phase_combine(P, bid, G); GRID_BAR(); }
    phase_combine(P, bid, G);
    GRID_BAR();
    if (PROBE == 4) { PH4(); GRID_BAR(); }
    PH4();
    GRID_BAR();
    if (PROBE == 6) { PH6(); GRID_BAR(); }
    PH6();
    GRID_BAR();
    if (PROBE == 8) { PH8(); GRID_BAR(); }
    PH8();
    GRID_BAR();
    if (PROBE == 9) { PH9DUMMY(); GRID_BAR(); }
    PH9();
    GRID_BAR();
    phase_final(P, bid, G);
}

extern "C" void kernel_launch(void* const* d_in, const int* in_sizes, int n_in, void* d_out, int out_size, void* d_ws, size_t ws_size, hipStream_t stream) {
    if (n_in != 17 || out_size != M * DM || ws_size < WS_END) { fprintf(stderr, "kernel_launch: unexpected shapes n_in %d out %d ws %zu\n", n_in, out_size, ws_size); return; }
    Params P{};
    P.x = (const float*)d_in[0]; P.g_mix = (const float*)d_in[1]; P.w_in = (const float*)d_in[2]; P.b_f = (const float*)d_in[3];
    P.lq1 = (const float*)d_in[4]; P.lk1 = (const float*)d_in[5]; P.lq2 = (const float*)d_in[6]; P.lk2 = (const float*)d_in[7];
    P.g_subln = (const float*)d_in[8]; P.w_pa = (const float*)d_in[9]; P.w_pb = (const float*)d_in[10]; P.w_o = (const float*)d_in[11];
    P.g_mlp = (const float*)d_in[12]; P.w_1 = (const float*)d_in[13]; P.w_2 = (const float*)d_in[14]; P.rel_table = (const float*)d_in[15]; P.g_final = (const float*)d_in[16];
    P.out = (float*)d_out; P.ws = (unsigned char*)d_ws;
    static int grid_blocks = 0;
    if (!grid_blocks) { int dev = 0, cus = 0, per_cu = 0; (void)hipGetDevice(&dev); (void)hipDeviceGetAttribute(&cus, hipDeviceAttributeMultiprocessorCount, dev);
        if (hipFuncSetAttribute((const void*)fwd_mega, hipFuncAttributeMaxDynamicSharedMemorySize, LDS_BYTES) != hipSuccess) fprintf(stderr, "kernel_launch: hipFuncSetAttribute failed\n");
        if (hipOccupancyMaxActiveBlocksPerMultiprocessor(&per_cu, fwd_mega, NTHREADS, LDS_BYTES) != hipSuccess || per_cu < 1) fprintf(stderr, "kernel_launch: occupancy query says %d blocks per CU\n", per_cu);
        (void)hipGetLastError();
        grid_blocks = cus;
    }
    void* args[] = {&P};
    hipError_t e = hipLaunchCooperativeKernel((void*)fwd_mega, dim3(grid_blocks), dim3(NTHREADS), args, LDS_BYTES, stream);
    if (e != hipSuccess) fprintf(stderr, "cooperative launch failed: %s (grid %d)\n", hipGetErrorString(e), grid_blocks);
}
```
